# Optimizing an MI355X kernel written in HIP

```python
import jax, jax.numpy as jnp
from jax import lax
import numpy as np

D_MODEL = 1024
BATCH = 8
SEQ = 4096
DEPTH = 1

ATT_HEAD_DIM = 64
ATT_HEADS_PER_GROUP = 8
DILATED_GROUPS = ((128, 1), (512, 4), (2048, 16))
N_ATT_GROUPS = len(DILATED_GROUPS)
ATT_WIDTH = N_ATT_GROUPS * ATT_HEADS_PER_GROUP * ATT_HEAD_DIM
ATT_OUT_WIDTH = ATT_HEADS_PER_GROUP * ATT_HEAD_DIM
BAND_BLOCK = 128
ROPE_THETA = 10000.0

RET_HEADS = 4
RET_QK_WIDTH = D_MODEL // 2
RET_V_WIDTH = D_MODEL
RET_KEY_DIM = RET_QK_WIDTH // RET_HEADS
RET_VALUE_DIM = RET_V_WIDTH // RET_HEADS
RET_CHUNK = 128

FFN_HIDDEN = ((8 * D_MODEL // 3 + 255) // 256) * 256
NORM_EPS = 1e-6

IN_SPLITS = (ATT_WIDTH, ATT_WIDTH, ATT_WIDTH,
             RET_QK_WIDTH, RET_QK_WIDTH, RET_V_WIDTH, RET_V_WIDTH,
             D_MODEL, D_MODEL)
IN_WIDTH = int(sum(IN_SPLITS))
IN_OFFSETS = tuple(int(o) for o in np.cumsum(IN_SPLITS)[:-1])

kernel_name = "hybrid_dilated_attn_retention_gated"


def rmsnorm(x, g):
    xf = x.astype(jnp.float32)
    y = xf * lax.rsqrt(jnp.mean(xf * xf, axis=-1, keepdims=True) + NORM_EPS)
    return (y * g.astype(jnp.float32)).astype(x.dtype)


def apply_rope(t, pos):
    hd = t.shape[-1]
    inv = ROPE_THETA ** (-jnp.arange(0, hd, 2, dtype=jnp.float32) / hd)
    ang = pos[:, None] * inv[None, :]
    c = jnp.cos(ang)[:, None, :]
    s = jnp.sin(ang)[:, None, :]
    tf = t.astype(jnp.float32)
    t1, t2 = tf[..., : hd // 2], tf[..., hd // 2:]
    out = jnp.concatenate([t1 * c - t2 * s, t2 * c + t1 * s], axis=-1)
    return out.astype(t.dtype)


def dilated_causal_group(q, k, v, window, dilation):
    B, S, H, hd = q.shape
    n_strides = window // dilation
    L = S // dilation
    nb = -(-L // BAND_BLOCK)
    Lp = nb * BAND_BLOCK

    def to_sub(t):
        t = t.reshape(B, L, dilation, H, hd).transpose(0, 2, 3, 1, 4)
        return jnp.pad(t, ((0, 0), (0, 0), (0, 0), (0, Lp - L), (0, 0)))

    qs, ks, vs = to_sub(q), to_sub(k), to_sub(v)
    qb = qs.reshape(B, dilation, H, nb, BAND_BLOCK, hd)

    def band(t):
        tp = jnp.pad(t, ((0, 0), (0, 0), (0, 0), (BAND_BLOCK, 0), (0, 0)))
        prev = tp[:, :, :, :Lp].reshape(B, dilation, H, nb, BAND_BLOCK, hd)
        cur = t.reshape(B, dilation, H, nb, BAND_BLOCK, hd)
        return jnp.concatenate([prev, cur], axis=4)

    kb, vb = band(ks), band(vs)
    scores = jnp.einsum('bdhnqc,bdhnkc->bdhnqk', qb, kb).astype(jnp.float32) * (hd ** -0.5)
    qi = jnp.arange(BAND_BLOCK)[:, None]
    kj = jnp.arange(2 * BAND_BLOCK)[None, :]
    dist = BAND_BLOCK + qi - kj
    key_idx = jnp.arange(nb)[:, None, None] * BAND_BLOCK + kj[None] - BAND_BLOCK
    mask = (dist >= 0)[None] & (dist <= n_strides)[None] & (key_idx >= 0)
    scores = jnp.where(mask, scores, jnp.float32(-1e30))
    m = jnp.max(scores, axis=-1, keepdims=True)
    p = jnp.exp(scores - m)
    l = jnp.sum(p, axis=-1, keepdims=True)
    o = jnp.einsum('bdhnqk,bdhnkc->bdhnqc', (p / l).astype(v.dtype), vb)
    lse = (m + jnp.log(l))[..., 0]
    o = o.reshape(B, dilation, H, Lp, hd)[:, :, :, :L].transpose(0, 3, 1, 2, 4).reshape(B, S, H, hd)
    lse = lse.reshape(B, dilation, H, Lp)[:, :, :, :L].transpose(0, 3, 1, 2).reshape(B, S, H)
    return o, lse


def dilated_attention(q, k, v, pos):
    B, S, _ = q.shape
    shp = (B, S, N_ATT_GROUPS, ATT_HEADS_PER_GROUP, ATT_HEAD_DIM)
    q = apply_rope(q.reshape(B, S, -1, ATT_HEAD_DIM), pos).reshape(shp)
    k = apply_rope(k.reshape(B, S, -1, ATT_HEAD_DIM), pos).reshape(shp)
    v = v.reshape(shp)
    outs, lses = [], []
    for g, (window, dilation) in enumerate(DILATED_GROUPS):
        o, lse = dilated_causal_group(q[:, :, g], k[:, :, g], v[:, :, g], window, dilation)
        outs.append(o)
        lses.append(lse)
    w = jax.nn.softmax(jnp.stack(lses, axis=0), axis=0)
    o = sum(w[g][..., None].astype(outs[g].dtype) * outs[g] for g in range(N_ATT_GROUPS))
    return o.reshape(B, S, ATT_OUT_WIDTH)


def retnet_theta_shift(t, pos):
    dk = t.shape[-1]
    ang_base = 1.0 / (ROPE_THETA ** jnp.linspace(0.0, 1.0, dk // 2, dtype=jnp.float32))
    ang = pos[:, None] * ang_base[None, :]
    c = jnp.cos(ang)[:, None, :]
    s = jnp.sin(ang)[:, None, :]
    t0, t1 = t[..., 0::2], t[..., 1::2]
    r0 = t0 * c - t1 * s
    r1 = t1 * c + t0 * s
    return jnp.stack([r0, r1], axis=-1).reshape(t.shape)


def retention(q, k, v, pos):
    B, S, _ = q.shape
    C = RET_CHUNK
    nc = S // C
    q = retnet_theta_shift(q.astype(jnp.float32).reshape(B, S, RET_HEADS, RET_KEY_DIM), pos)
    k = retnet_theta_shift(k.astype(jnp.float32).reshape(B, S, RET_HEADS, RET_KEY_DIM), pos)
    k = k * (RET_KEY_DIM ** -0.5)
    v = v.astype(jnp.float32).reshape(B, S, RET_HEADS, RET_VALUE_DIM)

    def chunks(t):
        return t.reshape(B, nc, C, RET_HEADS, t.shape[-1]).transpose(0, 3, 1, 2, 4)

    qc, kc, vc = chunks(q), chunks(k), chunks(v)
    log_g = jnp.log1p(-(2.0 ** (-5.0 - jnp.arange(RET_HEADS, dtype=jnp.float32))))
    idx = jnp.arange(C, dtype=jnp.float32)
    diff = idx[:, None] - idx[None, :]
    decay = jnp.where(diff[None] >= 0, jnp.exp(jnp.maximum(diff, 0.0)[None] * log_g[:, None, None]), 0.0)
    inner = jnp.einsum('bhnid,bhnjd->bhnij', qc, kc) * decay[None, :, None]
    inner = jnp.einsum('bhnij,bhnje->bhnie', inner, vc)
    zeta = jnp.exp((C - 1 - idx)[None, :] * log_g[:, None])
    xi = jnp.exp((idx + 1.0)[None, :] * log_g[:, None])
    kv = jnp.einsum('bhncd,bhnce->bhnde', kc * zeta[None, :, None, :, None], vc)
    chunk_decay = jnp.exp(C * log_g)

    def step(R, kv_c):
        return R * chunk_decay[None, :, None, None] + kv_c, R

    R0 = jnp.zeros((B, RET_HEADS, RET_KEY_DIM, RET_VALUE_DIM), jnp.float32)
    _, R_prev = lax.scan(step, R0, kv.transpose(2, 0, 1, 3, 4))
    cross = jnp.einsum('bhncd,nbhde->bhnce', qc * xi[None, :, None, :, None], R_prev)
    o = (inner + cross).transpose(0, 2, 3, 1, 4).reshape(B, S, RET_HEADS, RET_VALUE_DIM)
    mu = jnp.mean(o, axis=-1, keepdims=True)
    var = jnp.mean(jnp.square(o - mu), axis=-1, keepdims=True)
    o = (o - mu) * lax.rsqrt(var + NORM_EPS)
    return o.reshape(B, S, RET_V_WIDTH)


def setup_inputs(seed: int = 0) -> dict:
    key = jax.random.key(seed)
    ks = jax.random.split(key, 12)
    f = jnp.float32

    def w(k, shape, fan_in):
        return jax.random.normal(k, shape, f) * (fan_in ** -0.5)

    def gain(k, shape):
        return 1.0 + 0.02 * jax.random.normal(k, shape, f)

    return {
        "x": jax.random.normal(ks[0], (BATCH, SEQ, D_MODEL), f),
        "norm_mix_g": gain(ks[1], (DEPTH, D_MODEL)),
        "w_in": w(ks[2], (DEPTH, D_MODEL, IN_WIDTH), D_MODEL),
        "w_out_attn": w(ks[3], (DEPTH, ATT_OUT_WIDTH, D_MODEL), ATT_OUT_WIDTH),
        "w_out_ret": w(ks[4], (DEPTH, RET_V_WIDTH, D_MODEL), RET_V_WIDTH),
        "w_out": w(ks[5], (DEPTH, D_MODEL, D_MODEL), D_MODEL),
        "norm_ffn_g": gain(ks[6], (DEPTH, D_MODEL)),
        "w_ffn_gate": w(ks[7], (DEPTH, D_MODEL, FFN_HIDDEN), D_MODEL),
        "w_ffn_up": w(ks[8], (DEPTH, D_MODEL, FFN_HIDDEN), D_MODEL),
        "w_ffn_down": w(ks[9], (DEPTH, FFN_HIDDEN, D_MODEL), FFN_HIDDEN),
        "norm_final_g": gain(ks[10], (D_MODEL,)),
    }


def reference(x, norm_mix_g, w_in, w_out_attn, w_out_ret, w_out, norm_ffn_g,
              w_ffn_gate, w_ffn_up, w_ffn_down, norm_final_g):
    S = x.shape[1]
    pos = jnp.arange(S, dtype=jnp.float32)
    for layer in range(DEPTH):
        h = rmsnorm(x, norm_mix_g[layer])
        proj = h @ w_in[layer]
        (qa, ka, va, qr, kr, vr, gr, gate_a, gate_r) = jnp.split(proj, IN_OFFSETS, axis=-1)
        ya = dilated_attention(qa, ka, va, pos) @ w_out_attn[layer]
        yr = retention(qr, kr, vr, pos).astype(x.dtype) * jax.nn.silu(gr)
        yr = yr @ w_out_ret[layer]
        merged = jax.nn.sigmoid(gate_a) * ya + jax.nn.sigmoid(gate_r) * yr
        x = x + merged @ w_out[layer]
        h2 = rmsnorm(x, norm_ffn_g[layer])
        x = x + (jax.nn.silu(h2 @ w_ffn_gate[layer]) * (h2 @ w_ffn_up[layer])) @ w_ffn_down[layer]
    return rmsnorm(x, norm_final_g)
```

```cpp
#include <hip/hip_runtime.h>
#include <cstdio>
#include <cstdint>
namespace pg8 {
#define PG8_LAS __attribute__((address_space(3)))
typedef unsigned short bf16_t;
typedef short bf16x8 __attribute__((ext_vector_type(8)));
typedef float f32x4 __attribute__((ext_vector_type(4)));
typedef unsigned u32x4 __attribute__((ext_vector_type(4)));
constexpr int BM = 256, BK = 64, HALF = 128, HTB = HALF * BK * 2  , STAGE_BYTES = 8 * HTB, NXCD = 8, WGM = 8;

__host__ __device__ __forceinline__ int lds_byte(int r, int c) { const int st = (r >> 4) * 2 + (c >> 5), rr = r & 15, cc = c & 31, ob = rr * 64 + cc * 2; return st * 1024 + (ob ^ (((ob >> 9) & 1) << 5)); }
__host__ __device__ __forceinline__ void stage_rc(int b, int& R, int& C) { const int st = b / 1024, sb = b % 1024, swz = sb ^ (((sb >> 9) & 1) << 5); R = (st >> 1) * 16 + swz / 64; C = (st & 1) * 32 + (swz % 64) / 2; }
__host__ __device__ __forceinline__ int perm32(int rho) { const int n = rho >> 4, i = rho & 15; return 8 * (i >> 2) + 4 * n + (i & 3); }

struct Unit { int pm, pn; };
struct Gemm { const bf16_t* A; const bf16_t* Bt; int M, N, K; };

struct StaticOrder {
    int nM, nN, nwg, G, c;
    __host__ __device__ void init(int M, int N, int G_, int c_) { nM = M / BM; nN = N / BM; nwg = nM * nN; G = G_; c = c_; }
    __host__ __device__ bool next(int i, Unit& u) const {
        const long L = (long)i * G + c; if (L >= nwg) return false;
        int wgid = (int)L; { const int q = nwg / NXCD, r = nwg % NXCD, xcd = wgid % NXCD, off = wgid / NXCD; wgid = (xcd < r ? xcd * (q + 1) : r * (q + 1) + (xcd - r) * q) + off; }
        const int nig = WGM * nN, gid = wgid / nig, fm = gid * WGM, gsz = (nM - fm) < WGM ? (nM - fm) : WGM;
        u.pm = fm + ((wgid % nig) % gsz); u.pn = (wgid % nig) / gsz; return true;
    }
    __device__ __forceinline__ void a_ready(const Unit&) const {}
    __device__ __forceinline__ void done(const Unit&) const {}
};

__device__ __forceinline__ unsigned cvt_pk_bf16(float lo, float hi) { unsigned r; asm volatile("v_cvt_pk_bf16_f32 %0, %1, %2" : "=v"(r) : "v"(lo), "v"(hi)); return r; }
__device__ __forceinline__ float bf_lo(unsigned w) { return __uint_as_float(w << 16); }
__device__ __forceinline__ float bf_hi(unsigned w) { return __uint_as_float(w & 0xffff0000u); }
__device__ __forceinline__ float sigm(float x) { return __builtin_amdgcn_rcpf(1.f + __expf(-x)); }
__device__ __forceinline__ f32x4 sigm4(f32x4 v) { return (f32x4){sigm(v[0]), sigm(v[1]), sigm(v[2]), sigm(v[3])}; }
__device__ __forceinline__ u32x4 pack8(f32x4 a, f32x4 b) { u32x4 w; w.x = cvt_pk_bf16(a[0], a[1]); w.y = cvt_pk_bf16(a[2], a[3]); w.z = cvt_pk_bf16(b[0], b[1]); w.w = cvt_pk_bf16(b[2], b[3]); return w; }
__device__ __forceinline__ f32x4 unpk_lo(u32x4 w) { return (f32x4){bf_lo(w.x), bf_hi(w.x), bf_lo(w.y), bf_hi(w.y)}; }
__device__ __forceinline__ f32x4 unpk_hi(u32x4 w) { return (f32x4){bf_lo(w.z), bf_hi(w.z), bf_lo(w.w), bf_hi(w.w)}; }

struct EpiProjA {
    static constexpr bool PERM = true, AFTER_DRAIN = false;
    bf16_t *QA, *KA, *VA, *QR, *KR, *VR; const float *rope_cos, *rope_sin, *ret_cos, *ret_sin;
    __device__ __forceinline__ void operator()(const f32x4 (&acc)[2][2][4][2], const Unit& u, int wr, int wc, int fr, int fq) const {
        const int pn = u.pn, row0 = u.pm * BM + wr * 64 + fr;
        if (pn < 12) {
            bf16_t* dst = pn < 6 ? QA : KA; const int pt = pn < 6 ? pn : pn - 6; const int colA = pt * 256 + wc * 64 + 8 * fq;
#pragma unroll
            for (int ai = 0; ai < 2; ++ai)
#pragma unroll
                for (int m = 0; m < 4; ++m) { const int row = row0 + ai * HALF + m * 16, pos = row & 4095;
                    const f32x4 c0 = *(const f32x4*)(rope_cos + pos * 32 + 8 * fq), c1 = *(const f32x4*)(rope_cos + pos * 32 + 8 * fq + 4);
                    const f32x4 s0 = *(const f32x4*)(rope_sin + pos * 32 + 8 * fq), s1 = *(const f32x4*)(rope_sin + pos * 32 + 8 * fq + 4);
                    const f32x4 a0 = acc[ai][0][m][0], a1 = acc[ai][0][m][1], b0 = acc[ai][1][m][0], b1 = acc[ai][1][m][1];
                    const f32x4 o10 = a0 * c0 - b0 * s0, o11 = a1 * c1 - b1 * s1, o20 = b0 * c0 + a0 * s0, o21 = b1 * c1 + a1 * s1;
                    bf16_t* rp = dst + (size_t)row * 1536 + colA;
                    *(u32x4*)(rp) = pack8(o10, o11); *(u32x4*)(rp + 32) = pack8(o20, o21);
                    if (m & 1) asm volatile("" ::: "memory"); }
        } else if (pn >= 18 && pn < 22) {
            bf16_t* dst = pn < 20 ? QR : KR; const float sc = pn < 20 ? 1.0f : 0.08838834764831845f; const int colb = (pn & 1) * 256 + wc * 32 + 8 * fq;
#pragma unroll
            for (int ai = 0; ai < 2; ++ai)
#pragma unroll
                for (int m = 0; m < 4; ++m) { const int row = row0 + ai * HALF + m * 16, pos = row & 4095;
                    f32x4 c = *(const f32x4*)(ret_cos + pos * 64 + 16 * wc + 4 * fq), s = *(const f32x4*)(ret_sin + pos * 64 + 16 * wc + 4 * fq);
                    c = c * sc; s = s * sc;
#pragma unroll
                    for (int bj = 0; bj < 2; ++bj) { const f32x4 v0 = acc[ai][bj][m][0], v1 = acc[ai][bj][m][1];
                        const f32x4 r0 = (f32x4){v0[0] * c[0] - v0[1] * s[0], v0[1] * c[0] + v0[0] * s[0], v0[2] * c[1] - v0[3] * s[1], v0[3] * c[1] + v0[2] * s[1]};
                        const f32x4 r1 = (f32x4){v1[0] * c[2] - v1[1] * s[2], v1[1] * c[2] + v1[0] * s[2], v1[2] * c[3] - v1[3] * s[3], v1[3] * c[3] + v1[2] * s[3]};
                        *(u32x4*)(dst + (size_t)row * 512 + colb + bj * HALF) = pack8(r0, r1); }
                    if (m & 1) asm volatile("" ::: "memory"); }
        } else {
            bf16_t* dst; int ld, colt;
            if (pn < 18) { dst = VA; ld = 1536; colt = (pn - 12) * 256; } else { dst = VR; ld = 1024; colt = (pn - 22) * 256; }
            const int col0 = colt + wc * 32 + 8 * fq;
#pragma unroll
            for (int ai = 0; ai < 2; ++ai)
#pragma unroll
                for (int m = 0; m < 4; ++m) { bf16_t* rp = dst + (size_t)(row0 + ai * HALF + m * 16) * ld + col0;
#pragma unroll
                    for (int bj = 0; bj < 2; ++bj) *(u32x4*)(rp + bj * HALF) = pack8(acc[ai][bj][m][0], acc[ai][bj][m][1]); }
        }
    }
};

struct EpiGates {
    static constexpr bool PERM = true, AFTER_DRAIN = false;
    bf16_t* GR; size_t tstride;
    __device__ __forceinline__ void operator()(const f32x4 (&acc)[2][2][4][2], const Unit& u, int wr, int wc, int fr, int fq) const {
        const int t = u.pn >> 2, row0 = u.pm * BM + wr * 64 + fr, col0 = (u.pn & 3) * 256 + wc * 32 + 8 * fq;
        bf16_t* dst = GR + (size_t)t * tstride;
#pragma unroll
        for (int ai = 0; ai < 2; ++ai)
#pragma unroll
            for (int m = 0; m < 4; ++m) { bf16_t* rp = dst + (size_t)(row0 + ai * HALF + m * 16) * 1024 + col0;
#pragma unroll
                for (int bj = 0; bj < 2; ++bj) { f32x4 v0 = acc[ai][bj][m][0], v1 = acc[ai][bj][m][1]; f32x4 g0 = sigm4(v0), g1 = sigm4(v1);
                    if (t == 0) { g0 = g0 * v0; g1 = g1 * v1; }
                    *(u32x4*)(rp + bj * HALF) = pack8(g0, g1); } }
    }
};

template <bool ADD> struct EpiGateMul {
    static constexpr bool PERM = true, AFTER_DRAIN = false;
    const bf16_t* G; const bf16_t* T1in; bf16_t* O;
    __device__ __forceinline__ void operator()(const f32x4 (&acc)[2][2][4][2], const Unit& u, int wr, int wc, int fr, int fq) const {
        const int row0 = u.pm * BM + wr * 64 + fr, col0 = u.pn * 256 + wc * 32 + 8 * fq;
#pragma unroll
        for (int ai = 0; ai < 2; ++ai)
#pragma unroll
            for (int m = 0; m < 4; ++m) { const size_t off = (size_t)(row0 + ai * HALF + m * 16) * 1024 + col0;
#pragma unroll
                for (int bj = 0; bj < 2; ++bj) { const u32x4 g = *(const u32x4*)(G + off + bj * HALF);
                    f32x4 v0 = acc[ai][bj][m][0] * unpk_lo(g), v1 = acc[ai][bj][m][1] * unpk_hi(g);
                    if (ADD) { const u32x4 t = *(const u32x4*)(T1in + off + bj * HALF); v0 = v0 + unpk_lo(t); v1 = v1 + unpk_hi(t); }
                    *(u32x4*)(O + off + bj * HALF) = pack8(v0, v1); }
                if (m & 1) asm volatile("" ::: "memory"); }
    }
};

struct EpiResid {
    static constexpr bool PERM = true, AFTER_DRAIN = false;
    const float* base; float* out; bf16_t* XB; float* SSQ;
    __device__ __forceinline__ void operator()(const f32x4 (&acc)[2][2][4][2], const Unit& u, int wr, int wc, int fr, int fq) const {
        const int row0 = u.pm * BM + wr * 64 + fr, col0 = u.pn * 256 + wc * 32 + 8 * fq;
#pragma unroll
        for (int ai = 0; ai < 2; ++ai)
#pragma unroll
            for (int m = 0; m < 4; ++m) { const int row = row0 + ai * HALF + m * 16; const size_t off = (size_t)row * 1024 + col0; float s = 0.f;
#pragma unroll
                for (int bj = 0; bj < 2; ++bj) { const f32x4 x0 = *(const f32x4*)(base + off + bj * HALF), x1 = *(const f32x4*)(base + off + bj * HALF + 4);
                    const f32x4 v0 = acc[ai][bj][m][0] + x0, v1 = acc[ai][bj][m][1] + x1;
                    *(f32x4*)(out + off + bj * HALF) = v0; *(f32x4*)(out + off + bj * HALF + 4) = v1;
                    if (XB) *(u32x4*)(XB + off + bj * HALF) = pack8(v0, v1);
                    s += (v0[0] * v0[0] + v0[1] * v0[1]) + (v0[2] * v0[2] + v0[3] * v0[3]) + (v1[0] * v1[0] + v1[1] * v1[1]) + (v1[2] * v1[2] + v1[3] * v1[3]); }
                s += __shfl_xor(s, 16); s += __shfl_xor(s, 32);
                if (fq == 0) SSQ[(size_t)row * 16 + u.pn * 4 + wc] = s;
                if (m & 1) asm volatile("" ::: "memory"); }
    }
};

struct EpiFfnAct {
    static constexpr bool PERM = true, AFTER_DRAIN = false;
    const float* SSQ; bf16_t* ACT;
    __device__ __forceinline__ void operator()(const f32x4 (&acc)[2][2][4][2], const Unit& u, int wr, int wc, int fr, int fq) const {
        const int row0 = u.pm * BM + wr * 64 + fr, col0 = u.pn * 128 + wc * 32 + 8 * fq;
#pragma unroll
        for (int ai = 0; ai < 2; ++ai)
#pragma unroll
            for (int m = 0; m < 4; ++m) { const int row = row0 + ai * HALF + m * 16; const f32x4* sp = (const f32x4*)(SSQ + (size_t)row * 16);
                const f32x4 q = (sp[0] + sp[1]) + (sp[2] + sp[3]); const float rstd = __builtin_amdgcn_rsqf(((q[0] + q[1]) + (q[2] + q[3])) * (1.0f / 1024.0f) + 1e-6f);
                const f32x4 g0 = acc[ai][0][m][0] * rstd, g1 = acc[ai][0][m][1] * rstd, u0 = acc[ai][1][m][0] * rstd, u1 = acc[ai][1][m][1] * rstd;
                *(u32x4*)(ACT + (size_t)row * 2816 + col0) = pack8(g0 * sigm4(g0) * u0, g1 * sigm4(g1) * u1);
                if (m & 1) asm volatile("" ::: "memory"); }
    }
};

template <class Epi, class Sched, bool ALIGN_EPI = false, bool SP2 = false>
__device__ __forceinline__ void gemm_phase(PG8_LAS unsigned char* lds, const Gemm g, const Sched& S, const Epi& E) {
    const int tid = threadIdx.x, wid = __builtin_amdgcn_readfirstlane(tid >> 6), lane = tid & 63, wr = wid >> 2, wc = wid & 3, fr = lane & 15, fq = lane >> 4;
    const int K = g.K, nt = K / BK;
    unsigned voffA[2], voffB[2];
#pragma unroll
    for (int i = 0; i < 2; ++i) { int R, C; stage_rc(tid * 16 + i * 8192, R, C); const int Rb = Epi::PERM ? ((R & ~31) + perm32(R & 31)) : R;
        voffA[i] = (unsigned)(R * K + C) * 2u; voffB[i] = (unsigned)(Rb * K + C) * 2u; }
    const size_t kstep = (size_t)(BK * 2);
    const size_t hstep = (size_t)HALF * K * 2;
    const size_t tstep = 2 * hstep;
    const unsigned ldsw = (unsigned)wid * 1024u;
    const int aoff = lds_byte(wr * 64 + fr, fq * 8), boff = lds_byte(wc * 32 + fr, fq * 8);
#define PG8_SA(b, h) (((b) * 2 + (h)) * HTB)
#define PG8_SB(b, h) ((4 + (b) * 2 + (h)) * HTB)
#define PG8_STAGE(bufoff, gbase, voff) do { _Pragma("unroll") for (int _i = 0; _i < 2; ++_i) \
        __builtin_amdgcn_global_load_lds((const unsigned*)((const char*)(gbase) + (voff)[_i]), (PG8_LAS unsigned*)(lds + (bufoff) + ldsw + _i * 8192), 16, 0, 0); } while (0)
#define PG8_LDA(dst, b, h) do { _Pragma("unroll") for (int m = 0; m < 4; ++m) _Pragma("unroll") for (int k = 0; k < 2; ++k) dst[m][k] = *(const PG8_LAS bf16x8*)(lds + PG8_SA(b, h) + aoff + m * 2048 + k * 1024); } while (0)
#define PG8_LDB(dst, b, h) do { _Pragma("unroll") for (int n = 0; n < 2; ++n) _Pragma("unroll") for (int k = 0; k < 2; ++k) dst[n][k] = *(const PG8_LAS bf16x8*)(lds + PG8_SB(b, h) + boff + n * 2048 + k * 1024); } while (0)
#define PG8_MMA(ai, bj, At, Bt) do { __builtin_amdgcn_s_setprio(1); _Pragma("unroll") for (int m = 0; m < 4; ++m) _Pragma("unroll") for (int n = 0; n < 2; ++n) _Pragma("unroll") for (int k = 0; k < 2; ++k) \
        acc[ai][bj][m][n] = __builtin_amdgcn_mfma_f32_16x16x32_bf16(Bt[n][k], At[m][k], acc[ai][bj][m][n], 0, 0, 0); __builtin_amdgcn_s_setprio(0); } while (0)
#define PG8_WAIT_V(n) asm volatile("s_waitcnt vmcnt(" #n ")" ::: "memory")
#define PG8_WAIT_L(n) asm volatile("s_waitcnt lgkmcnt(" #n ")" ::: "memory")
#define PG8_BAR __builtin_amdgcn_s_barrier()
#define PG8_SCHED __builtin_amdgcn_sched_barrier(0)
    Unit cur, nxt; int ui = 0;
    if (!S.next(0, cur)) return;
    f32x4 acc[2][2][4][2];
#pragma unroll
    for (int a = 0; a < 2; ++a)
#pragma unroll
        for (int b = 0; b < 2; ++b)
#pragma unroll
            for (int m = 0; m < 4; ++m)
#pragma unroll
                for (int n = 0; n < 2; ++n) acc[a][b][m][n] = (f32x4){0.f, 0.f, 0.f, 0.f};
    bf16x8 At[4][2], B0[2][2], B1[2][2];
    const char* cA = (const char*)g.A + (size_t)cur.pm * tstep; const char* cB = (const char*)g.Bt + (size_t)cur.pn * tstep;
    S.a_ready(cur);
    if constexpr (SP2) {
        PG8_STAGE(PG8_SB(0, 0), cB, voffB); PG8_STAGE(PG8_SB(0, 1), cB + hstep, voffB); PG8_STAGE(PG8_SA(0, 0), cA, voffA); PG8_STAGE(PG8_SA(0, 1), cA + hstep, voffA);
        if (wr == 1) PG8_BAR;
        PG8_WAIT_V(2); PG8_BAR;
        PG8_STAGE(PG8_SB(1, 0), cB + kstep, voffB); PG8_STAGE(PG8_SA(1, 0), cA + kstep, voffA); PG8_STAGE(PG8_SB(1, 1), cB + hstep + kstep, voffB);
        PG8_WAIT_V(6); PG8_BAR;
    } else {
        PG8_STAGE(PG8_SB(0, 0), cB, voffB); PG8_STAGE(PG8_SA(0, 0), cA, voffA); PG8_STAGE(PG8_SB(0, 1), cB + hstep, voffB); PG8_STAGE(PG8_SA(0, 1), cA + hstep, voffA);
        if (wr == 1) PG8_BAR;
        PG8_WAIT_V(4); PG8_BAR;
        PG8_STAGE(PG8_SB(1, 0), cB + kstep, voffB); PG8_STAGE(PG8_SA(1, 0), cA + kstep, voffA); PG8_STAGE(PG8_SB(1, 1), cB + hstep + kstep, voffB);
        PG8_WAIT_V(6); PG8_BAR;
    }
    for (;;) {
        const bool has_next = S.next(ui + 1, nxt);
        const char* nA = has_next ? (const char*)g.A + (size_t)nxt.pm * tstep : cA; const char* nB = has_next ? (const char*)g.Bt + (size_t)nxt.pn * tstep : cB;
        for (int t = 0; t < nt; t += 2) {
            const bool last = (t == nt - 2);
            const char* a1 = cA + (size_t)(t + 1) * kstep;
            const char* a2 = last ? nA : cA + (size_t)(t + 2) * kstep; const char* b2 = last ? nB : cB + (size_t)(t + 2) * kstep;
            const char* a3 = a2 + kstep; const char* b3 = b2 + kstep;
            if (last && has_next) S.a_ready(nxt);
            if constexpr (SP2) {
            PG8_LDB(B0, 0, 0); PG8_LDB(B1, 0, 1); PG8_SCHED; PG8_LDA(At, 0, 0); PG8_STAGE(PG8_SA(1, 1), a1 + hstep, voffA);
            PG8_WAIT_V(8); PG8_WAIT_L(0); PG8_BAR; PG8_MMA(0, 0, At, B0); PG8_MMA(0, 1, At, B1); PG8_BAR; PG8_SCHED;
            PG8_LDA(At, 0, 1); PG8_STAGE(PG8_SB(0, 0), b2, voffB); PG8_STAGE(PG8_SB(0, 1), b2 + hstep, voffB); PG8_STAGE(PG8_SA(0, 0), a2, voffA);
            PG8_WAIT_V(8); PG8_WAIT_L(0); PG8_BAR; PG8_MMA(1, 0, At, B0); PG8_MMA(1, 1, At, B1); PG8_BAR; PG8_SCHED;
            PG8_LDB(B0, 1, 0); PG8_LDB(B1, 1, 1); PG8_SCHED; PG8_LDA(At, 1, 0); PG8_STAGE(PG8_SA(0, 1), a2 + hstep, voffA);
            PG8_WAIT_V(8); PG8_WAIT_L(0); PG8_BAR; PG8_MMA(0, 0, At, B0); PG8_MMA(0, 1, At, B1); PG8_BAR; PG8_SCHED;
            PG8_LDA(At, 1, 1); PG8_STAGE(PG8_SB(1, 0), b3, voffB); PG8_STAGE(PG8_SB(1, 1), b3 + hstep, voffB); PG8_STAGE(PG8_SA(1, 0), a3, voffA);
            PG8_WAIT_V(8); PG8_WAIT_L(0); PG8_BAR; PG8_MMA(1, 0, At, B0); PG8_MMA(1, 1, At, B1); PG8_BAR; PG8_SCHED;
            } else {
            PG8_LDB(B0, 0, 0); PG8_SCHED; PG8_LDA(At, 0, 0); PG8_STAGE(PG8_SA(1, 1), a1 + hstep, voffA);
            PG8_WAIT_L(8); PG8_BAR; PG8_WAIT_L(0); PG8_MMA(0, 0, At, B0); PG8_BAR; PG8_SCHED;
            PG8_LDB(B1, 0, 1); PG8_STAGE(PG8_SB(0, 0), b2, voffB);
            PG8_BAR; PG8_WAIT_L(0); PG8_MMA(0, 1, At, B1); PG8_BAR;
            PG8_LDA(At, 0, 1); PG8_STAGE(PG8_SA(0, 0), a2, voffA);
            PG8_BAR; PG8_WAIT_L(0); PG8_MMA(1, 0, At, B0); PG8_BAR; PG8_SCHED;
            PG8_STAGE(PG8_SB(0, 1), b2 + hstep, voffB);
            PG8_WAIT_V(6); PG8_BAR; PG8_MMA(1, 1, At, B1); PG8_BAR;
            PG8_LDB(B0, 1, 0); PG8_SCHED; PG8_LDA(At, 1, 0); PG8_STAGE(PG8_SA(0, 1), a2 + hstep, voffA);
            PG8_WAIT_L(8); PG8_BAR; PG8_WAIT_L(0); PG8_MMA(0, 0, At, B0); PG8_BAR; PG8_SCHED;
            PG8_LDB(B1, 1, 1); PG8_STAGE(PG8_SB(1, 0), b3, voffB);
            PG8_BAR; PG8_WAIT_L(0); PG8_MMA(0, 1, At, B1); PG8_BAR;
            PG8_LDA(At, 1, 1); PG8_STAGE(PG8_SA(1, 0), a3, voffA);
            PG8_BAR; PG8_WAIT_L(0); PG8_MMA(1, 0, At, B0); PG8_BAR; PG8_SCHED;
            PG8_STAGE(PG8_SB(1, 1), b3 + hstep, voffB);
            PG8_WAIT_V(6); PG8_BAR; PG8_MMA(1, 1, At, B1); PG8_BAR;
            }
        }
        if constexpr (ALIGN_EPI) { if (wr == 0) PG8_BAR; }
        if constexpr (!Epi::AFTER_DRAIN) { E(acc, cur, wr, wc, fr, fq); S.done(cur); }
        if (!has_next) break;
#pragma unroll
        for (int a = 0; a < 2; ++a)
#pragma unroll
            for (int b = 0; b < 2; ++b)
#pragma unroll
                for (int m = 0; m < 4; ++m)
#pragma unroll
                    for (int n = 0; n < 2; ++n) acc[a][b][m][n] = (f32x4){0.f, 0.f, 0.f, 0.f};
        cur = nxt; cA = nA; cB = nB; ++ui;
        if constexpr (ALIGN_EPI) { if (wr == 1) PG8_BAR; }
    }
    PG8_WAIT_V(0);
    if constexpr (!ALIGN_EPI) { if (wr == 0) PG8_BAR; }
    PG8_BAR;
    if constexpr (Epi::AFTER_DRAIN) { E.fused(acc, cur, wr, wc, fr, fq, lds, wid, lane); S.done(cur); }
#undef PG8_SA
#undef PG8_SB
#undef PG8_STAGE
#undef PG8_LDA
#undef PG8_LDB
#undef PG8_MMA
#undef PG8_WAIT_V
#undef PG8_WAIT_L
#undef PG8_BAR
#undef PG8_SCHED
}
}
#define GAS __attribute__((address_space(1)))
#define LAS __attribute__((address_space(3)))
typedef unsigned short bf16;
typedef unsigned v4u __attribute__((ext_vector_type(4)));
typedef float f32x4 __attribute__((ext_vector_type(4)));
typedef short bf16x8 __attribute__((ext_vector_type(8)));
typedef GAS unsigned gu32;
typedef GAS unsigned long long gu64;
#define RLX_AGENT __ATOMIC_RELAXED, __HIP_MEMORY_SCOPE_AGENT
#define LDS_WAIT() asm volatile("s_waitcnt lgkmcnt(0)" ::: "memory")
#define VM_WAIT() asm volatile("s_waitcnt vmcnt(0)" ::: "memory")
__device__ __forceinline__ unsigned long long rt() { return __builtin_amdgcn_s_memrealtime(); }
__device__ __forceinline__ unsigned f2bf(float f) { unsigned u = __builtin_bit_cast(unsigned, f); return (u + 0x7fffu + ((u >> 16) & 1u)) >> 16; }
__device__ __forceinline__ unsigned pk2(float lo, float hi) { return f2bf(lo) | (f2bf(hi) << 16); }

#define XB_TMO      128
#define XB_XCNT(j)  (256  + 64 * (j))
#define XB_XSUB(j)  (1280 + 64 * (j))
#define XB_XGEN(j)  (2304 + 64 * (j))
#define XB_TOP      3328
#define XB_TOPGEN   3392
#define XCD_BAR_WORDS 3456
#define XB_SPIN_CAP (1u << 18)

__device__ __forceinline__ unsigned xb_ld(unsigned* p)              { return __hip_atomic_load(p, __ATOMIC_RELAXED, __HIP_MEMORY_SCOPE_AGENT); }
__device__ __forceinline__ unsigned xb_add(unsigned* p, unsigned v) { return __hip_atomic_fetch_add(p, v, __ATOMIC_RELAXED, __HIP_MEMORY_SCOPE_AGENT); }
__device__ __forceinline__ unsigned xb_xcc_id() { return (unsigned)__builtin_amdgcn_s_getreg((3 << 11) | 20) & 0xFu; }
#define XB_SPIN(cond, bar) do { unsigned _sp = 0; while (cond) { __builtin_amdgcn_s_sleep(1); \
    if ((++_sp & 255u) == 0u) { if (xb_ld(&(bar)[XB_TMO])) break; if (_sp > XB_SPIN_CAP) { atomicAdd(&(bar)[XB_TMO], 1u); break; } } } } while (0)

struct XcdBarrier {
    unsigned* bar; unsigned x;
    volatile LAS unsigned* st;
};

__device__ __forceinline__ XcdBarrier xcd_barrier_post(unsigned* bar, volatile LAS unsigned* st) {
    XcdBarrier b; b.bar = bar; b.x = xb_xcc_id(); b.st = st;
    if (threadIdx.x == 0) (void)xb_add(&bar[XB_XCNT(b.x)], 1u);
    return b;
}
__device__ __forceinline__ void xcd_barrier_complete(unsigned* bar, unsigned x, unsigned& nloc, unsigned& nx) {
    const unsigned G = gridDim.x * gridDim.y * gridDim.z;
    unsigned sum, cnt, mine, sp = 0u;
    for (;;) {
        sum = 0u; cnt = 0u; mine = 0u;
#pragma unroll
        for (unsigned j = 0; j < 16; ++j) { const unsigned c = xb_ld(&bar[XB_XCNT(j)]); sum += c; cnt += (c > 0u) ? 1u : 0u; mine = (j == x) ? c : mine; }
        if (sum == G) break;
        __builtin_amdgcn_s_sleep(1);
        if ((++sp & 255u) == 0u) { if (xb_ld(&bar[XB_TMO])) break; if (sp > XB_SPIN_CAP) { atomicAdd(&bar[XB_TMO], 1u); break; } }
    }
    nloc = mine > 0u ? mine : 1u; nx = cnt > 0u ? cnt : 1u;
}

__device__ __forceinline__ void xcd_barrier(const XcdBarrier& b) {
    asm volatile("s_waitcnt vmcnt(0)" ::: "memory");
    __syncthreads();
    if (threadIdx.x == 0) {
        unsigned* bar = b.bar;
        __builtin_amdgcn_s_waitcnt(0);
        unsigned nloc = b.st[0], nx = b.st[1];
        if (nloc == 0u) { xcd_barrier_complete(bar, b.x, nloc, nx); b.st[0] = nloc; b.st[1] = nx; }
        const unsigned old = xb_add(&bar[XB_XSUB(b.x)], 1u);
        const unsigned gen = old / nloc;
        if (old + 1u == (gen + 1u) * nloc) {
            __builtin_amdgcn_fence(__ATOMIC_RELEASE, "agent");
            asm volatile("s_waitcnt vmcnt(0)" ::: "memory");
            const unsigned og = xb_add(&bar[XB_TOP], 1u);
            const unsigned tg = og / nx;
            if (og + 1u == (tg + 1u) * nx) xb_add(&bar[XB_TOPGEN], 1u);
            else XB_SPIN(xb_ld(&bar[XB_TOPGEN]) == tg, bar);
            __builtin_amdgcn_fence(__ATOMIC_ACQUIRE, "agent");
            xb_add(&bar[XB_XGEN(b.x)], 1u);
            asm volatile("s_waitcnt vmcnt(0)" ::: "memory");
        } else {
            XB_SPIN(xb_ld(&bar[XB_XGEN(b.x)]) == gen, bar);
            __builtin_amdgcn_fence(__ATOMIC_ACQUIRE, "agent");
            asm volatile("s_waitcnt vmcnt(0)" ::: "memory");
        }
    }
    __syncthreads();
}

constexpr int NWAVES = 8;
constexpr int SEQ = 4096, NB = 8, D = 1024, M = NB * SEQ;
constexpr int NQKV_A = 6656, NGATES = 3072, FFH = 2816, NPH = 10;
constexpr float EPS = 1e-6f;
#ifndef ONE_LAUNCH
#define ONE_LAUNCH 1
#endif
#ifndef NAIVE_ATT
#define NAIVE_ATT 1
#endif
#ifndef NAIVE_RET
#define NAIVE_RET 1
#endif

constexpr size_t MiB = 1u << 20;
constexpr size_t WS_CTL = 0, CTL_ZERO_BYTES = 1 * MiB;
constexpr size_t WS_WIN = 1 * MiB;
constexpr size_t WS_WOA = 20 * MiB;
constexpr size_t WS_WOR = 21 * MiB;
constexpr size_t WS_WO  = 23 * MiB;
constexpr size_t WS_WGU = 25 * MiB;
constexpr size_t WS_WD  = 36 * MiB;
constexpr size_t WS_ROPE = 42 * MiB;
constexpr size_t WS_RETCS = 43 * MiB;
constexpr size_t WS_SSQ1 = 45 * MiB;
constexpr size_t WS_SSQ2 = 47 * MiB;
constexpr size_t WS_LSE = 49 * MiB;
constexpr size_t WS_QA = 52 * MiB;
constexpr size_t WS_KA = 148 * MiB;
constexpr size_t WS_VA = 244 * MiB;
constexpr size_t WS_QR = 340 * MiB;
constexpr size_t WS_KR = 372 * MiB;
constexpr size_t WS_VR = 404 * MiB;
constexpr size_t WS_ATT = 468 * MiB;
constexpr size_t WS_END = 500 * MiB;
constexpr size_t WS_GR = WS_KA, WS_GA = WS_KA + 64 * MiB, WS_GT = WS_KA + 128 * MiB, WS_ACT = WS_KA, WS_T1 = WS_QA, WS_X1B = WS_QA, WS_MERGED = WS_QR;
constexpr int CW_TMO = 0, CW_CODE = 1, CW_BAR = 4096;

constexpr int RING_OFF = 0, RING_BYTES = 131072;
constexpr int LDSCTL_OFF = RING_BYTES, MISC_OFF = LDSCTL_OFF + 320;
constexpr int LDS_BYTES = 147456;

__device__ __forceinline__ float bf2f(bf16 v) { return __uint_as_float((unsigned)v << 16); }
__device__ __forceinline__ float wave_sum(float v) {
#pragma unroll
    for (int o = 1; o < 64; o <<= 1) v += __shfl_xor(v, o);
    return v;
}
__device__ __forceinline__ float ret_logg(int h) { return log1pf(-exp2f(-5.0f - (float)h)); }
__device__ __forceinline__ int kvidx(int dk, int dv) { const int dkl = dk & 31, hi = (dkl >> 2) & 1, rho = (dkl & 3) + 4 * (dkl >> 3); return (((dv >> 5) * 4 + (dk >> 5)) * 64 + (dv & 31) + 32 * hi) * 16 + rho; }

struct Frame {
    LAS unsigned char* lds; volatile LAS unsigned* MISC; gu32* ctl;
    int tid, lane, wave, G, gw, NGW;
    const float *x, *g_mix, *w_in, *w_oa, *w_or, *w_o, *g_ffn, *w_fg, *w_fu, *w_fd, *g_fin;
    float* out; unsigned char* ws;
};

__device__ __forceinline__ void p0_transpose_item(const float* W, int ldn, int K, int n0, int k0, bf16* WT, int dst_row0, const float* ks, LAS float* scr, int lane) {
#pragma unroll 8
    for (int i = 0; i < 32; ++i) { const int kk = 2 * i + (lane >> 5); float v = W[(size_t)(k0 + kk) * ldn + n0 + (lane & 31)]; if (ks) v *= ks[k0 + kk]; scr[kk * 33 + (lane & 31)] = v; }
    LDS_WAIT(); asm volatile("" ::: "memory");
    const int c = lane & 7;
#pragma unroll
    for (int j = 0; j < 4; ++j) { const int n = (lane >> 3) + 8 * j; const LAS float* s = scr + (8 * c) * 33 + n;
        v4u o; o.x = pk2(s[0 * 33], s[1 * 33]); o.y = pk2(s[2 * 33], s[3 * 33]); o.z = pk2(s[4 * 33], s[5 * 33]); o.w = pk2(s[6 * 33], s[7 * 33]);
        *(v4u*)(WT + (size_t)(dst_row0 + n) * K + k0 + 8 * c) = o; }
    LDS_WAIT(); asm volatile("" ::: "memory");
}
__device__ __forceinline__ void p0_prologue(Frame& F) {
    LAS float* scr = (LAS float*)(F.lds + RING_OFF + F.wave * 16384);
    bf16* WIN = (bf16*)(F.ws + WS_WIN); bf16* WOA = (bf16*)(F.ws + WS_WOA); bf16* WOR = (bf16*)(F.ws + WS_WOR); bf16* WO = (bf16*)(F.ws + WS_WO); bf16* WGU = (bf16*)(F.ws + WS_WGU); bf16* WD = (bf16*)(F.ws + WS_WD);
    constexpr int I0 = 16 * 304, I1 = 8 * 32, I2 = 16 * 32, I3 = 16 * 32, I4 = 16 * 176, I5 = 44 * 32, NITEMS = I0 + I1 + I2 + I3 + I4 + I5;
    for (int it = F.gw; it < NITEMS; it += F.NGW) {
        int r = it;
        if (r < I0) { const int kb = r / 304, G = r % 304; int sg = G;
            if (G < 96) { const int tile = G >> 3, j = G & 7; sg = tile * 8 + (j & 3) * 2 + (j >> 2); }
            p0_transpose_item(F.w_in, 9728, 1024, sg * 32, kb * 64, WIN, G * 32, nullptr, scr, F.lane); continue; } r -= I0;
        if (r < I1) { p0_transpose_item(F.w_oa, 1024, 512, (r % 32) * 32, (r / 32) * 64, WOA, (r % 32) * 32, nullptr, scr, F.lane); continue; } r -= I1;
        if (r < I2) { p0_transpose_item(F.w_or, 1024, 1024, (r % 32) * 32, (r / 32) * 64, WOR, (r % 32) * 32, nullptr, scr, F.lane); continue; } r -= I2;
        if (r < I3) { p0_transpose_item(F.w_o, 1024, 1024, (r % 32) * 32, (r / 32) * 64, WO, (r % 32) * 32, nullptr, scr, F.lane); continue; } r -= I3;
        if (r < I4) { const int kb = r / 176, G = r % 176, t = G >> 3, j = G & 7;
            p0_transpose_item(j < 4 ? F.w_fg : F.w_fu, FFH, 1024, (t * 4 + (j & 3)) * 32, kb * 64, WGU, G * 32, F.g_ffn, scr, F.lane); continue; } r -= I4;
        p0_transpose_item(F.w_fd, 1024, FFH, (r % 32) * 32, (r / 32) * 64, WD, (r % 32) * 32, nullptr, scr, F.lane);
    }
    float* rc = (float*)(F.ws + WS_ROPE); float* rs = rc + 4096 * 32; float* tc = (float*)(F.ws + WS_RETCS); float* ts = tc + 4096 * 64;
    const int gt = F.gw * 64 + F.lane, NGT = F.NGW * 64;
    for (int i = gt; i < 4096 * 32; i += NGT) { const int pos = i >> 5, k = i & 31; const float inv = powf(10000.0f, -(float)(2 * k) / 64.0f); const float ang = (float)pos * inv; rc[i] = cosf(ang); rs[i] = sinf(ang); }
    for (int i = gt; i < 4096 * 64; i += NGT) { const int pos = i >> 6, k = i & 63; const float ab = 1.0f / powf(10000.0f, (float)k / 63.0f); const float ang = (float)pos * ab; tc[i] = cosf(ang); ts[i] = sinf(ang); }
    bf16* XN = (bf16*)F.out;
    for (int m = F.gw; m < M; m += F.NGW) {
        const f32x4* xr = (const f32x4*)(F.x + (size_t)m * D) + F.lane; const f32x4* gr = (const f32x4*)F.g_mix + F.lane;
        f32x4 v[4]; float s = 0.f;
#pragma unroll
        for (int j = 0; j < 4; ++j) { v[j] = xr[64 * j]; s += (v[j].x * v[j].x + v[j].y * v[j].y) + (v[j].z * v[j].z + v[j].w * v[j].w); }
        const float rstd = 1.0f / sqrtf(wave_sum(s) * (1.f / D) + EPS);
        unsigned long long* o8 = (unsigned long long*)(XN + (size_t)m * D) + F.lane;
#pragma unroll
        for (int j = 0; j < 4; ++j) { const f32x4 g = gr[64 * j]; o8[64 * j] = (unsigned long long)pk2(v[j].x * rstd * g.x, v[j].y * rstd * g.y) | ((unsigned long long)pk2(v[j].z * rstd * g.z, v[j].w * rstd * g.w) << 32); }
    }
}

__device__ __forceinline__ void att_naive(Frame& F) {
    bf16* QA = (bf16*)(F.ws + WS_QA); const bf16* KA = (const bf16*)(F.ws + WS_KA); const bf16* VA = (const bf16*)(F.ws + WS_VA); float* LSE = (float*)(F.ws + WS_LSE);
    for (int item = F.gw; item < M * 24; item += F.NGW) {
        const int m = item / 24, hg = item % 24, g = hg >> 3, d = g == 0 ? 1 : (g == 1 ? 4 : 16), s = m & 4095;
        const size_t co = (size_t)hg * 64 + F.lane;
        const float q = bf2f(QA[(size_t)m * 1536 + co]);
        float mx = -1e30f, l = 0.f, o = 0.f;
        for (int j = 0; j <= 128; ++j) { if (s - j * d < 0) break; const size_t mk = (size_t)(m - j * d) * 1536 + co;
            const float sc = wave_sum(q * bf2f(KA[mk])) * 0.125f; const float mn = fmaxf(mx, sc), a = __expf(mx - mn), p = __expf(sc - mn);
            l = l * a + p; o = o * a + p * bf2f(VA[mk]); mx = mn; }
        QA[(size_t)m * 1536 + co] = (bf16)f2bf(o / l);
        if (F.lane == 0) LSE[(size_t)m * 24 + hg] = mx + __logf(l);
    }
}
__device__ __forceinline__ void att_merge(Frame& F) {
    const bf16* OG = (const bf16*)(F.ws + WS_QA); const float* LSE = (const float*)(F.ws + WS_LSE); bf16* ATT = (bf16*)(F.ws + WS_ATT);
    const int gt = F.gw * 64 + F.lane, NGT = F.NGW * 64;
    for (int it = gt; it < M * 64; it += NGT) { const int m = it >> 6, c = it & 63, head = c >> 3;
        const float l0 = LSE[(size_t)m * 24 + head], l1 = LSE[(size_t)m * 24 + 8 + head], l2 = LSE[(size_t)m * 24 + 16 + head];
        const float mx = fmaxf(l0, fmaxf(l1, l2)); float w0 = __expf(l0 - mx), w1 = __expf(l1 - mx), w2 = __expf(l2 - mx); const float inv = 1.0f / (w0 + w1 + w2); w0 *= inv; w1 *= inv; w2 *= inv;
        const v4u a = *(const v4u*)(OG + (size_t)m * 1536 + c * 8), b = *(const v4u*)(OG + (size_t)m * 1536 + 512 + c * 8), e = *(const v4u*)(OG + (size_t)m * 1536 + 1024 + c * 8);
        v4u o;
#define MRG(f) o.f = pk2(w0 * __uint_as_float(a.f << 16) + w1 * __uint_as_float(b.f << 16) + w2 * __uint_as_float(e.f << 16), w0 * __uint_as_float(a.f & 0xffff0000u) + w1 * __uint_as_float(b.f & 0xffff0000u) + w2 * __uint_as_float(e.f & 0xffff0000u))
        MRG(x); MRG(y); MRG(z); MRG(w);
#undef MRG
        *(v4u*)(ATT + (size_t)m * 512 + c * 8) = o; }
}
__device__ __forceinline__ void ret_kv_naive(Frame& F) {
    const bf16* KR = (const bf16*)(F.ws + WS_KR); const bf16* VR = (const bf16*)(F.ws + WS_VR); bf16* KVS = (bf16*)((unsigned char*)F.out + 64 * MiB);
    const int gt = F.gw * 64 + F.lane, NGT = F.NGW * 64;
    for (long it = gt; it < 1024l * 32768l; it += NGT) { const int unit = (int)(it >> 15), e = (int)(it & 32767), dv = e & 255, dk = e >> 8;
        const int bh = unit >> 5, n = unit & 31, b = bh >> 2, h = bh & 3; const size_t row0 = (size_t)b * SEQ + n * 128; const float lg = ret_logg(h);
        float acc = 0.f;
        for (int j = 0; j < 128; ++j) acc += __expf((float)(127 - j) * lg) * bf2f(KR[(row0 + j) * 512 + h * 128 + dk]) * bf2f(VR[(row0 + j) * 1024 + h * 256 + dv]);
        KVS[(size_t)unit * 32768 + kvidx(dk, dv)] = (bf16)f2bf(acc); }
}
__device__ __forceinline__ void ret_scan(Frame& F) {
    bf16* KVS = (bf16*)((unsigned char*)F.out + 64 * MiB);
    const int gt = F.gw * 64 + F.lane, NGT = F.NGW * 64;
    for (int t = gt; t < 32 * 4096; t += NGT) { const int bh = t >> 12, e8 = t & 4095, h = bh & 3; const float cd = __expf(128.0f * ret_logg(h));
        float r[8];
#pragma unroll
        for (int i = 0; i < 8; ++i) r[i] = 0.f;
        v4u* p = (v4u*)(KVS + (size_t)bh * 32 * 32768 + (size_t)e8 * 8);
#pragma unroll 4
        for (int n = 0; n < 32; ++n) { const v4u kv = p[(size_t)n * 4096]; v4u o; o.x = pk2(r[0], r[1]); o.y = pk2(r[2], r[3]); o.z = pk2(r[4], r[5]); o.w = pk2(r[6], r[7]); p[(size_t)n * 4096] = o;
            r[0] = r[0] * cd + __uint_as_float(kv.x << 16); r[1] = r[1] * cd + __uint_as_float(kv.x & 0xffff0000u); r[2] = r[2] * cd + __uint_as_float(kv.y << 16); r[3] = r[3] * cd + __uint_as_float(kv.y & 0xffff0000u);
            r[4] = r[4] * cd + __uint_as_float(kv.z << 16); r[5] = r[5] * cd + __uint_as_float(kv.z & 0xffff0000u); r[6] = r[6] * cd + __uint_as_float(kv.w << 16); r[7] = r[7] * cd + __uint_as_float(kv.w & 0xffff0000u); } }
}
__device__ __forceinline__ void ret_out_naive(Frame& F) {
    const bf16* QR = (const bf16*)(F.ws + WS_QR); const bf16* KR = (const bf16*)(F.ws + WS_KR); const bf16* VR = (const bf16*)(F.ws + WS_VR); const bf16* GR = (const bf16*)(F.ws + WS_GR);
    const bf16* KVS = (const bf16*)((unsigned char*)F.out + 64 * MiB); bf16* RET = (bf16*)F.out;
    for (int item = F.gw; item < M * 4; item += F.NGW) { const int m = item >> 2, h = item & 3, i = m & 127, n = (m & 4095) >> 7, b = m >> 12; const size_t row0 = (size_t)m - i; const float lg = ret_logg(h);
        const float q0 = bf2f(QR[(size_t)m * 512 + h * 128 + F.lane]), q1 = bf2f(QR[(size_t)m * 512 + h * 128 + 64 + F.lane]);
        float o0 = 0.f, o1 = 0.f, o2 = 0.f, o3 = 0.f;
        for (int j = 0; j <= i; ++j) { const bf16* kp = KR + (row0 + j) * 512 + h * 128 + F.lane; const float s = wave_sum(q0 * bf2f(kp[0]) + q1 * bf2f(kp[64])) * __expf((float)(i - j) * lg);
            const bf16* vp = VR + (row0 + j) * 1024 + h * 256 + F.lane; o0 += s * bf2f(vp[0]); o1 += s * bf2f(vp[64]); o2 += s * bf2f(vp[128]); o3 += s * bf2f(vp[192]); }
        const bf16* R = KVS + (size_t)((b * 4 + h) * 32 + n) * 32768; const float xi = __expf((float)(i + 1) * lg);
        float c0 = 0.f, c1 = 0.f, c2 = 0.f, c3 = 0.f;
        for (int dk = 0; dk < 128; ++dk) { const float qd = dk < 64 ? __shfl(q0, dk) : __shfl(q1, dk - 64);
            c0 += qd * bf2f(R[kvidx(dk, F.lane)]); c1 += qd * bf2f(R[kvidx(dk, F.lane + 64)]); c2 += qd * bf2f(R[kvidx(dk, F.lane + 128)]); c3 += qd * bf2f(R[kvidx(dk, F.lane + 192)]); }
        o0 += xi * c0; o1 += xi * c1; o2 += xi * c2; o3 += xi * c3;
        const float mu = wave_sum((o0 + o1) + (o2 + o3)) * (1.0f / 256.0f); o0 -= mu; o1 -= mu; o2 -= mu; o3 -= mu;
        const float var = wave_sum((o0 * o0 + o1 * o1) + (o2 * o2 + o3 * o3)) * (1.0f / 256.0f), rs = 1.0f / sqrtf(var + EPS);
        const bf16* gp = GR + (size_t)m * 1024 + h * 256 + F.lane; bf16* op = RET + (size_t)m * 1024 + h * 256 + F.lane;
        op[0] = (bf16)f2bf(o0 * rs * bf2f(gp[0])); op[64] = (bf16)f2bf(o1 * rs * bf2f(gp[64])); op[128] = (bf16)f2bf(o2 * rs * bf2f(gp[128])); op[192] = (bf16)f2bf(o3 * rs * bf2f(gp[192])); }
}
__device__ __forceinline__ void final_norm(Frame& F) {
    const float* SSQ = (const float*)(F.ws + WS_SSQ2);
    for (int m = F.gw; m < M; m += F.NGW) { const f32x4* sp = (const f32x4*)(SSQ + (size_t)m * 16); const f32x4 q = (sp[0] + sp[1]) + (sp[2] + sp[3]);
        const float rstd = 1.0f / sqrtf(((q[0] + q[1]) + (q[2] + q[3])) * (1.f / D) + EPS);
        f32x4* xr = (f32x4*)(F.out + (size_t)m * D) + F.lane; const f32x4* gr = (const f32x4*)F.g_fin + F.lane;
#pragma unroll
        for (int j = 0; j < 4; ++j) xr[64 * j] = xr[64 * j] * rstd * gr[64 * j]; }
}

struct Args { const float* in[11]; float* out; unsigned char* ws; int ph_lo, ph_hi, li, pad; };
__global__ void __launch_bounds__(NWAVES * 64, 2) mega_fwd(Args args) {
    extern __shared__ __attribute__((aligned(16))) unsigned char lds[];
    Frame F;
    F.lds = (LAS unsigned char*)lds; F.MISC = (volatile LAS unsigned*)(F.lds + MISC_OFF);
    F.tid = threadIdx.x; F.lane = F.tid & 63; F.wave = __builtin_amdgcn_readfirstlane(F.tid >> 6);
    F.G = gridDim.x; F.gw = (int)blockIdx.x * NWAVES + F.wave; F.NGW = F.G * NWAVES;
    F.ws = args.ws; F.ctl = (gu32*)(args.ws + WS_CTL); F.out = args.out;
    F.x = args.in[0]; F.g_mix = args.in[1]; F.w_in = args.in[2]; F.w_oa = args.in[3]; F.w_or = args.in[4]; F.w_o = args.in[5]; F.g_ffn = args.in[6]; F.w_fg = args.in[7]; F.w_fu = args.in[8]; F.w_fd = args.in[9]; F.g_fin = args.in[10];
    for (int u = F.tid; u < (LDS_BYTES - LDSCTL_OFF) / 4; u += NWAVES * 64) ((LAS unsigned*)(F.lds + LDSCTL_OFF))[u] = 0u;
    __syncthreads();
    XcdBarrier bar; bar.bar = (unsigned*)(F.ctl + CW_BAR); bar.x = 0; bar.st = nullptr;
    if (ONE_LAUNCH) bar = xcd_barrier_post((unsigned*)(F.ctl + CW_BAR), F.MISC + 8);
    const int lo = args.ph_lo, hi = args.ph_hi;
#define IN(k) (lo <= (k) && (k) < hi)
#define SEAM(k) do { if (IN(k) && IN((k) + 1)) xcd_barrier(bar); } while (0)
    typedef pg8::bf16_t pb;
    pb* const XN = (pb*)F.out; pb* const RET = (pb*)F.out;
    pb* const WIN = (pb*)(F.ws + WS_WIN);

    if (IN(0)) { p0_prologue(F); } SEAM(0);

    if (IN(1)) {
        pg8::Gemm g{XN, WIN, M, NQKV_A, D}; pg8::StaticOrder S; S.init(M, NQKV_A, F.G, (int)blockIdx.x);
        const float* rc = (const float*)(F.ws + WS_ROPE); const float* tc = (const float*)(F.ws + WS_RETCS);
        pg8::EpiProjA E{(pb*)(F.ws + WS_QA), (pb*)(F.ws + WS_KA), (pb*)(F.ws + WS_VA), (pb*)(F.ws + WS_QR), (pb*)(F.ws + WS_KR), (pb*)(F.ws + WS_VR), rc, rc + 4096 * 32, tc, tc + 4096 * 64};
        pg8::gemm_phase<pg8::EpiProjA, pg8::StaticOrder, true, true>(F.lds + RING_OFF, g, S, E);
    } SEAM(1);

    if (IN(2)) { att_naive(F); ret_kv_naive(F); } SEAM(2);

    if (IN(3)) {
        ret_scan(F);
        pg8::Gemm g{XN, WIN + (size_t)NQKV_A * D, M, NGATES, D}; pg8::StaticOrder S; S.init(M, NGATES, F.G, (int)blockIdx.x);
        pg8::EpiGates E{(pb*)(F.ws + WS_GR), (size_t)(WS_GA - WS_GR) / 2};
        pg8::gemm_phase<pg8::EpiGates, pg8::StaticOrder, true, true>(F.lds + RING_OFF, g, S, E);
    } SEAM(3);

    if (IN(4)) { ret_out_naive(F); att_merge(F); } SEAM(4);

    if (IN(5)) {
        { pg8::Gemm g{(pb*)(F.ws + WS_ATT), (pb*)(F.ws + WS_WOA), M, D, 512}; pg8::StaticOrder S; S.init(M, D, F.G, (int)blockIdx.x);
          pg8::EpiGateMul<false> E{(pb*)(F.ws + WS_GA), nullptr, (pb*)(F.ws + WS_T1)};
          pg8::gemm_phase<pg8::EpiGateMul<false>, pg8::StaticOrder, true, true>(F.lds + RING_OFF, g, S, E); }
        VM_WAIT(); __syncthreads();
        { pg8::Gemm g{RET, (pb*)(F.ws + WS_WOR), M, D, D}; pg8::StaticOrder S; S.init(M, D, F.G, (int)blockIdx.x);
          pg8::EpiGateMul<true> E{(pb*)(F.ws + WS_GT), (pb*)(F.ws + WS_T1), (pb*)(F.ws + WS_MERGED)};
          pg8::gemm_phase<pg8::EpiGateMul<true>, pg8::StaticOrder, true, true>(F.lds + RING_OFF, g, S, E); }
    } SEAM(5);

    if (IN(6)) {
        pg8::Gemm g{(pb*)(F.ws + WS_MERGED), (pb*)(F.ws + WS_WO), M, D, D}; pg8::StaticOrder S; S.init(M, D, F.G, (int)blockIdx.x);
        pg8::EpiResid E{F.x, F.out, (pb*)(F.ws + WS_X1B), (float*)(F.ws + WS_SSQ1)};
        pg8::gemm_phase<pg8::EpiResid, pg8::StaticOrder, true, true>(F.lds + RING_OFF, g, S, E);
    } SEAM(6);

    if (IN(7)) {
        pg8::Gemm g{(pb*)(F.ws + WS_X1B), (pb*)(F.ws + WS_WGU), M, 2 * FFH, D}; pg8::StaticOrder S; S.init(M, 2 * FFH, F.G, (int)blockIdx.x);
        pg8::EpiFfnAct E{(const float*)(F.ws + WS_SSQ1), (pb*)(F.ws + WS_ACT)};
        pg8::gemm_phase<pg8::EpiFfnAct, pg8::StaticOrder, true, true>(F.lds + RING_OFF, g, S, E);
    } SEAM(7);

    if (IN(8)) {
        pg8::Gemm g{(pb*)(F.ws + WS_ACT), (pb*)(F.ws + WS_WD), M, D, FFH}; pg8::StaticOrder S; S.init(M, D, F.G, (int)blockIdx.x);
        pg8::EpiResid E{F.out, F.out, nullptr, (float*)(F.ws + WS_SSQ2)};
        pg8::gemm_phase<pg8::EpiResid, pg8::StaticOrder, true, true>(F.lds + RING_OFF, g, S, E);
    } SEAM(8);

    if (IN(9)) { final_norm(F); }
#undef IN
#undef SEAM
}

extern "C" void kernel_launch(void* const* d_in, const int* in_sizes, int n_in, void* d_out, int out_size, void* d_ws, size_t ws_size, hipStream_t stream) {
    static int grid = 0;
    if (grid == 0) {
        if (n_in != 11 || in_sizes[0] != M * D || out_size != M * D || ws_size < WS_END) { fprintf(stderr, "kernel_launch: unexpected shapes / workspace (n_in %d, in0 %d, out %d, ws %zu)\n", n_in, n_in > 0 ? in_sizes[0] : -1, out_size, ws_size); grid = -1; return; }
        int dev = 0, cus = 0;
        if (hipGetDevice(&dev) != hipSuccess || hipDeviceGetAttribute(&cus, hipDeviceAttributeMultiprocessorCount, dev) != hipSuccess) { grid = -1; return; }
        if (hipFuncSetAttribute((const void*)mega_fwd, hipFuncAttributeMaxDynamicSharedMemorySize, LDS_BYTES) != hipSuccess) { fprintf(stderr, "kernel_launch: hipFuncSetAttribute failed\n"); grid = -1; return; }
        (void)hipGetLastError();
        grid = cus;
    }
    if (grid < 0) return;
    if (hipMemsetAsync((char*)d_ws + WS_CTL, 0, CTL_ZERO_BYTES, stream) != hipSuccess) return;
    Args a{};
    for (int i = 0; i < 11; ++i) a.in[i] = (const float*)d_in[i];
    a.out = (float*)d_out; a.ws = (unsigned char*)d_ws;
    if (ONE_LAUNCH) { a.ph_lo = 0; a.ph_hi = NPH; a.li = 0; hipLaunchKernelGGL(mega_fwd, dim3(grid), dim3(NWAVES * 64), LDS_BYTES, stream, a); }
    else for (int p = 0; p < NPH; ++p) { a.ph_lo = p; a.ph_hi = p + 1; a.li = p; hipLaunchKernelGGL(mega_fwd, dim3(grid), dim3(NWAVES * 64), LDS_BYTES, stream, a); }
}
```

```cpp
#include <hip/hip_runtime.h>
#include <cstdio>
#include <cstdint>
namespace pg8 {
#define PG8_LAS __attribute__((address_space(3)))
typedef unsigned short bf16_t;
typedef short bf16x8 __attribute__((ext_vector_type(8)));
typedef float f32x4 __attribute__((ext_vector_type(4)));
typedef unsigned u32x4 __attribute__((ext_vector_type(4)));
constexpr int BM = 256, BK = 64, HALF = 128, HTB = HALF * BK * 2  , STAGE_BYTES = 8 * HTB, NXCD = 8, WGM = 8;

__host__ __device__ __forceinline__ int lds_byte(int r, int c) { const int st = (r >> 4) * 2 + (c >> 5), rr = r & 15, cc = c & 31, ob = rr * 64 + cc * 2; return st * 1024 + (ob ^ (((ob >> 9) & 1) << 5)); }
__host__ __device__ __forceinline__ void stage_rc(int b, int& R, int& C) { const int st = b / 1024, sb = b % 1024, swz = sb ^ (((sb >> 9) & 1) << 5); R = (st >> 1) * 16 + swz / 64; C = (st & 1) * 32 + (swz % 64) / 2; }
__host__ __device__ __forceinline__ int perm32(int rho) { const int n = rho >> 4, i = rho & 15; return 8 * (i >> 2) + 4 * n + (i & 3); }

struct Unit { int pm, pn; };
struct Gemm { const bf16_t* A; const bf16_t* Bt; int M, N, K; };

struct StaticOrder {
    int nM, nN, nwg, G, c;
    __host__ __device__ void init(int M, int N, int G_, int c_) { nM = M / BM; nN = N / BM; nwg = nM * nN; G = G_; c = c_; }
    __host__ __device__ bool next(int i, Unit& u) const {
        const long L = (long)i * G + c; if (L >= nwg) return false;
        int wgid = (int)L; { const int q = nwg / NXCD, r = nwg % NXCD, xcd = wgid % NXCD, off = wgid / NXCD; wgid = (xcd < r ? xcd * (q + 1) : r * (q + 1) + (xcd - r) * q) + off; }
        const int nig = WGM * nN, gid = wgid / nig, fm = gid * WGM, gsz = (nM - fm) < WGM ? (nM - fm) : WGM;
        u.pm = fm + ((wgid % nig) % gsz); u.pn = (wgid % nig) / gsz; return true;
    }
    __device__ __forceinline__ void a_ready(const Unit&) const {}
    __device__ __forceinline__ void done(const Unit&) const {}
};

__device__ __forceinline__ unsigned cvt_pk_bf16(float lo, float hi) { typedef float f2_ __attribute__((ext_vector_type(2))); typedef __bf16 b2_ __attribute__((ext_vector_type(2))); const f2_ v = {lo, hi}; return __builtin_bit_cast(unsigned, __builtin_convertvector(v, b2_)); }
__device__ __forceinline__ float bf_lo(unsigned w) { return __uint_as_float(w << 16); }
__device__ __forceinline__ float bf_hi(unsigned w) { return __uint_as_float(w & 0xffff0000u); }
__device__ __forceinline__ float sigm(float x) { return __builtin_amdgcn_rcpf(1.f + __expf(-x)); }
__device__ __forceinline__ f32x4 sigm4(f32x4 v) { return (f32x4){sigm(v[0]), sigm(v[1]), sigm(v[2]), sigm(v[3])}; }
__device__ __forceinline__ u32x4 pack8(f32x4 a, f32x4 b) { u32x4 w; w.x = cvt_pk_bf16(a[0], a[1]); w.y = cvt_pk_bf16(a[2], a[3]); w.z = cvt_pk_bf16(b[0], b[1]); w.w = cvt_pk_bf16(b[2], b[3]); return w; }
__device__ __forceinline__ f32x4 unpk_lo(u32x4 w) { return (f32x4){bf_lo(w.x), bf_hi(w.x), bf_lo(w.y), bf_hi(w.y)}; }
__device__ __forceinline__ f32x4 unpk_hi(u32x4 w) { return (f32x4){bf_lo(w.z), bf_hi(w.z), bf_lo(w.w), bf_hi(w.w)}; }

struct EpiProjA {
    static constexpr bool PERM = true, AFTER_DRAIN = false;
    bf16_t *QA, *KA, *VA, *QR, *KR, *VR; const float *rope_cos, *rope_sin, *ret_cos, *ret_sin;
    __device__ __forceinline__ void operator()(const f32x4 (&acc)[2][2][4][2], const Unit& u, int wr, int wc, int fr, int fq) const {
        const int pn = u.pn, row0 = u.pm * BM + wr * 64 + fr;
        if (pn < 12) {
            bf16_t* dst = pn < 6 ? QA : KA; const int pt = pn < 6 ? pn : pn - 6; const int colA = pt * 256 + wc * 64 + 8 * fq;
#pragma unroll
            for (int ai = 0; ai < 2; ++ai)
#pragma unroll
                for (int m = 0; m < 4; ++m) { const int row = row0 + ai * HALF + m * 16, pos = row & 4095;
                    const f32x4 c0 = *(const f32x4*)(rope_cos + pos * 32 + 8 * fq), c1 = *(const f32x4*)(rope_cos + pos * 32 + 8 * fq + 4);
                    const f32x4 s0 = *(const f32x4*)(rope_sin + pos * 32 + 8 * fq), s1 = *(const f32x4*)(rope_sin + pos * 32 + 8 * fq + 4);
                    const f32x4 a0 = acc[ai][0][m][0], a1 = acc[ai][0][m][1], b0 = acc[ai][1][m][0], b1 = acc[ai][1][m][1];
                    const f32x4 o10 = a0 * c0 - b0 * s0, o11 = a1 * c1 - b1 * s1, o20 = b0 * c0 + a0 * s0, o21 = b1 * c1 + a1 * s1;
                    bf16_t* rp = dst + (size_t)row * 1536 + colA;
                    *(u32x4*)(rp) = pack8(o10, o11); *(u32x4*)(rp + 32) = pack8(o20, o21);
                    if (m & 1) asm volatile("" ::: "memory"); }
        } else if (pn >= 18 && pn < 22) {
            bf16_t* dst = pn < 20 ? QR : KR; const float sc = pn < 20 ? 1.0f : 0.08838834764831845f; const int colb = (pn & 1) * 256 + wc * 32 + 8 * fq;
#pragma unroll
            for (int ai = 0; ai < 2; ++ai)
#pragma unroll
                for (int m = 0; m < 4; ++m) { const int row = row0 + ai * HALF + m * 16, pos = row & 4095;
                    f32x4 c = *(const f32x4*)(ret_cos + pos * 64 + 16 * wc + 4 * fq), s = *(const f32x4*)(ret_sin + pos * 64 + 16 * wc + 4 * fq);
                    c = c * sc; s = s * sc;
#pragma unroll
                    for (int bj = 0; bj < 2; ++bj) { const f32x4 v0 = acc[ai][bj][m][0], v1 = acc[ai][bj][m][1];
                        const f32x4 r0 = (f32x4){v0[0] * c[0] - v0[1] * s[0], v0[1] * c[0] + v0[0] * s[0], v0[2] * c[1] - v0[3] * s[1], v0[3] * c[1] + v0[2] * s[1]};
                        const f32x4 r1 = (f32x4){v1[0] * c[2] - v1[1] * s[2], v1[1] * c[2] + v1[0] * s[2], v1[2] * c[3] - v1[3] * s[3], v1[3] * c[3] + v1[2] * s[3]};
                        *(u32x4*)(dst + (size_t)row * 512 + colb + bj * HALF) = pack8(r0, r1); }
                    if (m & 1) asm volatile("" ::: "memory"); }
        } else {
            bf16_t* dst; int ld, colt;
            if (pn < 18) { dst = VA; ld = 1536; colt = (pn - 12) * 256; } else { dst = VR; ld = 1024; colt = (pn - 22) * 256; }
            const int col0 = colt + wc * 32 + 8 * fq;
#pragma unroll
            for (int ai = 0; ai < 2; ++ai)
#pragma unroll
                for (int m = 0; m < 4; ++m) { bf16_t* rp = dst + (size_t)(row0 + ai * HALF + m * 16) * ld + col0;
#pragma unroll
                    for (int bj = 0; bj < 2; ++bj) *(u32x4*)(rp + bj * HALF) = pack8(acc[ai][bj][m][0], acc[ai][bj][m][1]); }
        }
    }
};

struct EpiGates {
    static constexpr bool PERM = true, AFTER_DRAIN = false;
    bf16_t* GR; size_t tstride;
    __device__ __forceinline__ void operator()(const f32x4 (&acc)[2][2][4][2], const Unit& u, int wr, int wc, int fr, int fq) const {
        const int t = u.pn >> 2, row0 = u.pm * BM + wr * 64 + fr, col0 = (u.pn & 3) * 256 + wc * 32 + 8 * fq;
        bf16_t* dst = GR + (size_t)t * tstride;
#pragma unroll
        for (int ai = 0; ai < 2; ++ai)
#pragma unroll
            for (int m = 0; m < 4; ++m) { bf16_t* rp = dst + (size_t)(row0 + ai * HALF + m * 16) * 1024 + col0;
#pragma unroll
                for (int bj = 0; bj < 2; ++bj) { f32x4 v0 = acc[ai][bj][m][0], v1 = acc[ai][bj][m][1]; f32x4 g0 = sigm4(v0), g1 = sigm4(v1);
                    if (t == 0) { g0 = g0 * v0; g1 = g1 * v1; }
                    *(u32x4*)(rp + bj * HALF) = pack8(g0, g1); } }
    }
};

template <bool ADD> struct EpiGateMul {
    static constexpr bool PERM = true, AFTER_DRAIN = false;
    const bf16_t* G; const bf16_t* T1in; bf16_t* O;
    __device__ __forceinline__ void operator()(const f32x4 (&acc)[2][2][4][2], const Unit& u, int wr, int wc, int fr, int fq) const {
        const int row0 = u.pm * BM + wr * 64 + fr, col0 = u.pn * 256 + wc * 32 + 8 * fq;
#pragma unroll
        for (int ai = 0; ai < 2; ++ai)
#pragma unroll
            for (int m = 0; m < 4; ++m) { const size_t off = (size_t)(row0 + ai * HALF + m * 16) * 1024 + col0;
#pragma unroll
                for (int bj = 0; bj < 2; ++bj) { const u32x4 g = *(const u32x4*)(G + off + bj * HALF);
                    f32x4 v0 = acc[ai][bj][m][0] * unpk_lo(g), v1 = acc[ai][bj][m][1] * unpk_hi(g);
                    if (ADD) { const u32x4 t = *(const u32x4*)(T1in + off + bj * HALF); v0 = v0 + unpk_lo(t); v1 = v1 + unpk_hi(t); }
                    *(u32x4*)(O + off + bj * HALF) = pack8(v0, v1); }
                if (m & 1) asm volatile("" ::: "memory"); }
    }
};

struct EpiResid {
    static constexpr bool PERM = true, AFTER_DRAIN = false;
    const float* base; float* out; bf16_t* XB; float* SSQ;
    __device__ __forceinline__ void operator()(const f32x4 (&acc)[2][2][4][2], const Unit& u, int wr, int wc, int fr, int fq) const {
        const int row0 = u.pm * BM + wr * 64 + fr, col0 = u.pn * 256 + wc * 32 + 8 * fq;
#pragma unroll
        for (int ai = 0; ai < 2; ++ai)
#pragma unroll
            for (int m = 0; m < 4; ++m) { const int row = row0 + ai * HALF + m * 16; const size_t off = (size_t)row * 1024 + col0; float s = 0.f;
#pragma unroll
                for (int bj = 0; bj < 2; ++bj) { const f32x4 x0 = *(const f32x4*)(base + off + bj * HALF), x1 = *(const f32x4*)(base + off + bj * HALF + 4);
                    const f32x4 v0 = acc[ai][bj][m][0] + x0, v1 = acc[ai][bj][m][1] + x1;
                    *(f32x4*)(out + off + bj * HALF) = v0; *(f32x4*)(out + off + bj * HALF + 4) = v1;
                    if (XB) *(u32x4*)(XB + off + bj * HALF) = pack8(v0, v1);
                    s += (v0[0] * v0[0] + v0[1] * v0[1]) + (v0[2] * v0[2] + v0[3] * v0[3]) + (v1[0] * v1[0] + v1[1] * v1[1]) + (v1[2] * v1[2] + v1[3] * v1[3]); }
                s += __shfl_xor(s, 16); s += __shfl_xor(s, 32);
                if (fq == 0) SSQ[(size_t)row * 16 + u.pn * 4 + wc] = s;
                if (m & 1) asm volatile("" ::: "memory"); }
    }
};

struct EpiFfnAct {
    static constexpr bool PERM = true, AFTER_DRAIN = false;
    const float* SSQ; bf16_t* ACT;
    __device__ __forceinline__ void operator()(const f32x4 (&acc)[2][2][4][2], const Unit& u, int wr, int wc, int fr, int fq) const {
        const int row0 = u.pm * BM + wr * 64 + fr, col0 = u.pn * 128 + wc * 32 + 8 * fq;
#pragma unroll
        for (int ai = 0; ai < 2; ++ai)
#pragma unroll
            for (int m = 0; m < 4; ++m) { const int row = row0 + ai * HALF + m * 16; const f32x4* sp = (const f32x4*)(SSQ + (size_t)row * 16);
                const f32x4 q = (sp[0] + sp[1]) + (sp[2] + sp[3]); const float rstd = __builtin_amdgcn_rsqf(((q[0] + q[1]) + (q[2] + q[3])) * (1.0f / 1024.0f) + 1e-6f);
                const f32x4 g0 = acc[ai][0][m][0] * rstd, g1 = acc[ai][0][m][1] * rstd, u0 = acc[ai][1][m][0] * rstd, u1 = acc[ai][1][m][1] * rstd;
                *(u32x4*)(ACT + (size_t)row * 2816 + col0) = pack8(g0 * sigm4(g0) * u0, g1 * sigm4(g1) * u1);
                if (m & 1) asm volatile("" ::: "memory"); }
    }
};

template <class Epi, class Sched, bool ALIGN_EPI = false, bool SP2 = false>
__device__ __forceinline__ void gemm_phase(PG8_LAS unsigned char* lds, const Gemm g, const Sched& S, const Epi& E) {
    const int tid = threadIdx.x, wid = __builtin_amdgcn_readfirstlane(tid >> 6), lane = tid & 63, wr = wid >> 2, wc = wid & 3, fr = lane & 15, fq = lane >> 4;
    const int K = g.K, nt = K / BK;
    unsigned voffA[2], voffB[2];
#pragma unroll
    for (int i = 0; i < 2; ++i) { int R, C; stage_rc(tid * 16 + i * 8192, R, C); const int Rb = Epi::PERM ? ((R & ~31) + perm32(R & 31)) : R;
        voffA[i] = (unsigned)(R * K + C) * 2u; voffB[i] = (unsigned)(Rb * K + C) * 2u; }
    const size_t kstep = (size_t)(BK * 2);
    const size_t hstep = (size_t)HALF * K * 2;
    const size_t tstep = 2 * hstep;
    const unsigned ldsw = (unsigned)wid * 1024u;
    const int aoff = lds_byte(wr * 64 + fr, fq * 8), boff = lds_byte(wc * 32 + fr, fq * 8);
#define PG8_SA(b, h) (((b) * 2 + (h)) * HTB)
#define PG8_SB(b, h) ((4 + (b) * 2 + (h)) * HTB)
#define PG8_STAGE(bufoff, gbase, voff) do { _Pragma("unroll") for (int _i = 0; _i < 2; ++_i) \
        __builtin_amdgcn_global_load_lds((const unsigned*)((const char*)(gbase) + (voff)[_i]), (PG8_LAS unsigned*)(lds + (bufoff) + ldsw + _i * 8192), 16, 0, 0); } while (0)
#define PG8_LDA(dst, b, h) do { _Pragma("unroll") for (int m = 0; m < 4; ++m) _Pragma("unroll") for (int k = 0; k < 2; ++k) dst[m][k] = *(const PG8_LAS bf16x8*)(lds + PG8_SA(b, h) + aoff + m * 2048 + k * 1024); } while (0)
#define PG8_LDB(dst, b, h) do { _Pragma("unroll") for (int n = 0; n < 2; ++n) _Pragma("unroll") for (int k = 0; k < 2; ++k) dst[n][k] = *(const PG8_LAS bf16x8*)(lds + PG8_SB(b, h) + boff + n * 2048 + k * 1024); } while (0)
#define PG8_MMA(ai, bj, At, Bt) do { __builtin_amdgcn_s_setprio(1); _Pragma("unroll") for (int m = 0; m < 4; ++m) _Pragma("unroll") for (int n = 0; n < 2; ++n) _Pragma("unroll") for (int k = 0; k < 2; ++k) \
        acc[ai][bj][m][n] = __builtin_amdgcn_mfma_f32_16x16x32_bf16(Bt[n][k], At[m][k], acc[ai][bj][m][n], 0, 0, 0); __builtin_amdgcn_s_setprio(0); } while (0)
#define PG8_WAIT_V(n) asm volatile("s_waitcnt vmcnt(" #n ")" ::: "memory")
#define PG8_WAIT_L(n) asm volatile("s_waitcnt lgkmcnt(" #n ")" ::: "memory")
#define PG8_BAR __builtin_amdgcn_s_barrier()
#define PG8_SCHED __builtin_amdgcn_sched_barrier(0)
    Unit cur, nxt; int ui = 0;
    if (!S.next(0, cur)) return;
    f32x4 acc[2][2][4][2];
#pragma unroll
    for (int a = 0; a < 2; ++a)
#pragma unroll
        for (int b = 0; b < 2; ++b)
#pragma unroll
            for (int m = 0; m < 4; ++m)
#pragma unroll
                for (int n = 0; n < 2; ++n) acc[a][b][m][n] = (f32x4){0.f, 0.f, 0.f, 0.f};
    bf16x8 At[4][2], B0[2][2], B1[2][2];
    const char* cA = (const char*)g.A + (size_t)cur.pm * tstep; const char* cB = (const char*)g.Bt + (size_t)cur.pn * tstep;
    S.a_ready(cur);
    if constexpr (SP2) {
        PG8_STAGE(PG8_SB(0, 0), cB, voffB); PG8_STAGE(PG8_SB(0, 1), cB + hstep, voffB); PG8_STAGE(PG8_SA(0, 0), cA, voffA); PG8_STAGE(PG8_SA(0, 1), cA + hstep, voffA);
        if (wr == 1) PG8_BAR;
        PG8_WAIT_V(2); PG8_BAR;
        PG8_STAGE(PG8_SB(1, 0), cB + kstep, voffB); PG8_STAGE(PG8_SA(1, 0), cA + kstep, voffA); PG8_STAGE(PG8_SB(1, 1), cB + hstep + kstep, voffB);
        PG8_WAIT_V(6); PG8_BAR;
    } else {
        PG8_STAGE(PG8_SB(0, 0), cB, voffB); PG8_STAGE(PG8_SA(0, 0), cA, voffA); PG8_STAGE(PG8_SB(0, 1), cB + hstep, voffB); PG8_STAGE(PG8_SA(0, 1), cA + hstep, voffA);
        if (wr == 1) PG8_BAR;
        PG8_WAIT_V(4); PG8_BAR;
        PG8_STAGE(PG8_SB(1, 0), cB + kstep, voffB); PG8_STAGE(PG8_SA(1, 0), cA + kstep, voffA); PG8_STAGE(PG8_SB(1, 1), cB + hstep + kstep, voffB);
        PG8_WAIT_V(6); PG8_BAR;
    }
    for (;;) {
        const bool has_next = S.next(ui + 1, nxt);
        const char* nA = has_next ? (const char*)g.A + (size_t)nxt.pm * tstep : cA; const char* nB = has_next ? (const char*)g.Bt + (size_t)nxt.pn * tstep : cB;
        for (int t = 0; t < nt; t += 2) {
            const bool last = (t == nt - 2);
            const char* a1 = cA + (size_t)(t + 1) * kstep;
            const char* a2 = last ? nA : cA + (size_t)(t + 2) * kstep; const char* b2 = last ? nB : cB + (size_t)(t + 2) * kstep;
            const char* a3 = a2 + kstep; const char* b3 = b2 + kstep;
            if (last && has_next) S.a_ready(nxt);
            if constexpr (SP2) {
            PG8_LDB(B0, 0, 0); PG8_LDB(B1, 0, 1); PG8_SCHED; PG8_LDA(At, 0, 0); PG8_STAGE(PG8_SA(1, 1), a1 + hstep, voffA);
            PG8_WAIT_V(8); PG8_WAIT_L(0); PG8_BAR; PG8_MMA(0, 0, At, B0); PG8_MMA(0, 1, At, B1); PG8_BAR; PG8_SCHED;
            PG8_LDA(At, 0, 1); PG8_STAGE(PG8_SB(0, 0), b2, voffB); PG8_STAGE(PG8_SB(0, 1), b2 + hstep, voffB); PG8_STAGE(PG8_SA(0, 0), a2, voffA);
            PG8_WAIT_V(8); PG8_WAIT_L(0); PG8_BAR; PG8_MMA(1, 0, At, B0); PG8_MMA(1, 1, At, B1); PG8_BAR; PG8_SCHED;
            PG8_LDB(B0, 1, 0); PG8_LDB(B1, 1, 1); PG8_SCHED; PG8_LDA(At, 1, 0); PG8_STAGE(PG8_SA(0, 1), a2 + hstep, voffA);
            PG8_WAIT_V(8); PG8_WAIT_L(0); PG8_BAR; PG8_MMA(0, 0, At, B0); PG8_MMA(0, 1, At, B1); PG8_BAR; PG8_SCHED;
            PG8_LDA(At, 1, 1); PG8_STAGE(PG8_SB(1, 0), b3, voffB); PG8_STAGE(PG8_SB(1, 1), b3 + hstep, voffB); PG8_STAGE(PG8_SA(1, 0), a3, voffA);
            PG8_WAIT_V(8); PG8_WAIT_L(0); PG8_BAR; PG8_MMA(1, 0, At, B0); PG8_MMA(1, 1, At, B1); PG8_BAR; PG8_SCHED;
            } else {
            PG8_LDB(B0, 0, 0); PG8_SCHED; PG8_LDA(At, 0, 0); PG8_STAGE(PG8_SA(1, 1), a1 + hstep, voffA);
            PG8_WAIT_L(8); PG8_BAR; PG8_WAIT_L(0); PG8_MMA(0, 0, At, B0); PG8_BAR; PG8_SCHED;
            PG8_LDB(B1, 0, 1); PG8_STAGE(PG8_SB(0, 0), b2, voffB);
            PG8_BAR; PG8_WAIT_L(0); PG8_MMA(0, 1, At, B1); PG8_BAR;
            PG8_LDA(At, 0, 1); PG8_STAGE(PG8_SA(0, 0), a2, voffA);
            PG8_BAR; PG8_WAIT_L(0); PG8_MMA(1, 0, At, B0); PG8_BAR; PG8_SCHED;
            PG8_STAGE(PG8_SB(0, 1), b2 + hstep, voffB);
            PG8_WAIT_V(6); PG8_BAR; PG8_MMA(1, 1, At, B1); PG8_BAR;
            PG8_LDB(B0, 1, 0); PG8_SCHED; PG8_LDA(At, 1, 0); PG8_STAGE(PG8_SA(0, 1), a2 + hstep, voffA);
            PG8_WAIT_L(8); PG8_BAR; PG8_WAIT_L(0); PG8_MMA(0, 0, At, B0); PG8_BAR; PG8_SCHED;
            PG8_LDB(B1, 1, 1); PG8_STAGE(PG8_SB(1, 0), b3, voffB);
            PG8_BAR; PG8_WAIT_L(0); PG8_MMA(0, 1, At, B1); PG8_BAR;
            PG8_LDA(At, 1, 1); PG8_STAGE(PG8_SA(1, 0), a3, voffA);
            PG8_BAR; PG8_WAIT_L(0); PG8_MMA(1, 0, At, B0); PG8_BAR; PG8_SCHED;
            PG8_STAGE(PG8_SB(1, 1), b3 + hstep, voffB);
            PG8_WAIT_V(6); PG8_BAR; PG8_MMA(1, 1, At, B1); PG8_BAR;
            }
        }
        if constexpr (ALIGN_EPI) { if (wr == 0) PG8_BAR; }
        if constexpr (!Epi::AFTER_DRAIN) { E(acc, cur, wr, wc, fr, fq); S.done(cur); }
        if (!has_next) break;
#pragma unroll
        for (int a = 0; a < 2; ++a)
#pragma unroll
            for (int b = 0; b < 2; ++b)
#pragma unroll
                for (int m = 0; m < 4; ++m)
#pragma unroll
                    for (int n = 0; n < 2; ++n) acc[a][b][m][n] = (f32x4){0.f, 0.f, 0.f, 0.f};
        cur = nxt; cA = nA; cB = nB; ++ui;
        if constexpr (ALIGN_EPI) { if (wr == 1) PG8_BAR; }
    }
    PG8_WAIT_V(0);
    if constexpr (!ALIGN_EPI) { if (wr == 0) PG8_BAR; }
    PG8_BAR;
    if constexpr (Epi::AFTER_DRAIN) { E.fused(acc, cur, wr, wc, fr, fq, lds, wid, lane); S.done(cur); }
#undef PG8_SA
#undef PG8_SB
#undef PG8_STAGE
#undef PG8_LDA
#undef PG8_LDB
#undef PG8_MMA
#undef PG8_WAIT_V
#undef PG8_WAIT_L
#undef PG8_BAR
#undef PG8_SCHED
}
}
#define GAS __attribute__((address_space(1)))
#define LAS __attribute__((address_space(3)))
typedef unsigned short bf16;
typedef unsigned v4u __attribute__((ext_vector_type(4)));
typedef float f32x4 __attribute__((ext_vector_type(4)));
typedef short bf16x8 __attribute__((ext_vector_type(8)));
typedef GAS unsigned gu32;
typedef GAS unsigned long long gu64;
#define RLX_AGENT __ATOMIC_RELAXED, __HIP_MEMORY_SCOPE_AGENT
#define LDS_WAIT() asm volatile("s_waitcnt lgkmcnt(0)" ::: "memory")
#define VM_WAIT() asm volatile("s_waitcnt vmcnt(0)" ::: "memory")
__device__ __forceinline__ unsigned long long rt() { return __builtin_amdgcn_s_memrealtime(); }
__device__ __forceinline__ unsigned f2bf(float f) { unsigned u = __builtin_bit_cast(unsigned, f); return (u + 0x7fffu + ((u >> 16) & 1u)) >> 16; }
__device__ __forceinline__ unsigned pk2(float lo, float hi) { return f2bf(lo) | (f2bf(hi) << 16); }

#define XB_TMO      128
#define XB_XCNT(j)  (256  + 64 * (j))
#define XB_XSUB(j)  (1280 + 64 * (j))
#define XB_XGEN(j)  (2304 + 64 * (j))
#define XB_TOP      3328
#define XB_TOPGEN   3392
#define XCD_BAR_WORDS 3456
#define XB_SPIN_CAP (1u << 18)

__device__ __forceinline__ unsigned xb_ld(unsigned* p)              { return __hip_atomic_load(p, __ATOMIC_RELAXED, __HIP_MEMORY_SCOPE_AGENT); }
__device__ __forceinline__ unsigned xb_add(unsigned* p, unsigned v) { return __hip_atomic_fetch_add(p, v, __ATOMIC_RELAXED, __HIP_MEMORY_SCOPE_AGENT); }
__device__ __forceinline__ unsigned xb_xcc_id() { return (unsigned)__builtin_amdgcn_s_getreg((3 << 11) | 20) & 0xFu; }
#define XB_SPIN(cond, bar) do { unsigned _sp = 0; while (cond) { __builtin_amdgcn_s_sleep(1); \
    if ((++_sp & 255u) == 0u) { if (xb_ld(&(bar)[XB_TMO])) break; if (_sp > XB_SPIN_CAP) { atomicAdd(&(bar)[XB_TMO], 1u); break; } } } } while (0)

struct XcdBarrier {
    unsigned* bar; unsigned x;
    volatile LAS unsigned* st;
};

__device__ __forceinline__ XcdBarrier xcd_barrier_post(unsigned* bar, volatile LAS unsigned* st) {
    XcdBarrier b; b.bar = bar; b.x = xb_xcc_id(); b.st = st;
    if (threadIdx.x == 0) (void)xb_add(&bar[XB_XCNT(b.x)], 1u);
    return b;
}
__device__ __forceinline__ void xcd_barrier_complete(unsigned* bar, unsigned x, unsigned& nloc, unsigned& nx) {
    const unsigned G = gridDim.x * gridDim.y * gridDim.z;
    unsigned sum, cnt, mine, sp = 0u;
    for (;;) {
        sum = 0u; cnt = 0u; mine = 0u;
#pragma unroll
        for (unsigned j = 0; j < 16; ++j) { const unsigned c = xb_ld(&bar[XB_XCNT(j)]); sum += c; cnt += (c > 0u) ? 1u : 0u; mine = (j == x) ? c : mine; }
        if (sum == G) break;
        __builtin_amdgcn_s_sleep(1);
        if ((++sp & 255u) == 0u) { if (xb_ld(&bar[XB_TMO])) break; if (sp > XB_SPIN_CAP) { atomicAdd(&bar[XB_TMO], 1u); break; } }
    }
    nloc = mine > 0u ? mine : 1u; nx = cnt > 0u ? cnt : 1u;
}

__device__ __forceinline__ void xcd_barrier(const XcdBarrier& b) {
    asm volatile("s_waitcnt vmcnt(0)" ::: "memory");
    __syncthreads();
    if (threadIdx.x == 0) {
        unsigned* bar = b.bar;
        __builtin_amdgcn_s_waitcnt(0);
        unsigned nloc = b.st[0], nx = b.st[1];
        if (nloc == 0u) { xcd_barrier_complete(bar, b.x, nloc, nx); b.st[0] = nloc; b.st[1] = nx; }
        const unsigned old = xb_add(&bar[XB_XSUB(b.x)], 1u);
        const unsigned gen = old / nloc;
        if (old + 1u == (gen + 1u) * nloc) {
            __builtin_amdgcn_fence(__ATOMIC_RELEASE, "agent");
            asm volatile("s_waitcnt vmcnt(0)" ::: "memory");
            const unsigned og = xb_add(&bar[XB_TOP], 1u);
            const unsigned tg = og / nx;
            if (og + 1u == (tg + 1u) * nx) xb_add(&bar[XB_TOPGEN], 1u);
            else XB_SPIN(xb_ld(&bar[XB_TOPGEN]) == tg, bar);
            __builtin_amdgcn_fence(__ATOMIC_ACQUIRE, "agent");
            xb_add(&bar[XB_XGEN(b.x)], 1u);
            asm volatile("s_waitcnt vmcnt(0)" ::: "memory");
        } else {
            XB_SPIN(xb_ld(&bar[XB_XGEN(b.x)]) == gen, bar);
            __builtin_amdgcn_fence(__ATOMIC_ACQUIRE, "agent");
            asm volatile("s_waitcnt vmcnt(0)" ::: "memory");
        }
    }
    __syncthreads();
}

constexpr int NWAVES = 8;
constexpr int SEQ = 4096, NB = 8, D = 1024, M = NB * SEQ;
constexpr int NQKV_A = 6656, NGATES = 3072, FFH = 2816, NPH = 10;
constexpr float EPS = 1e-6f;
#ifndef ONE_LAUNCH
#define ONE_LAUNCH 1
#endif
#ifndef NAIVE_ATT
#define NAIVE_ATT 0
#endif
#ifndef NAIVE_RET
#define NAIVE_RET 0
#endif

constexpr size_t MiB = 1u << 20;
constexpr size_t WS_CTL = 0, CTL_ZERO_BYTES = 1 * MiB;
constexpr size_t WS_WIN = 1 * MiB;
constexpr size_t WS_WOA = 20 * MiB;
constexpr size_t WS_WOR = 21 * MiB;
constexpr size_t WS_WO  = 23 * MiB;
constexpr size_t WS_WGU = 25 * MiB;
constexpr size_t WS_WD  = 36 * MiB;
constexpr size_t WS_ROPE = 42 * MiB;
constexpr size_t WS_RETCS = 43 * MiB;
constexpr size_t WS_SSQ1 = 45 * MiB;
constexpr size_t WS_SSQ2 = 47 * MiB;
constexpr size_t WS_LSE = 49 * MiB;
constexpr size_t WS_QA = 52 * MiB;
constexpr size_t WS_KA = 148 * MiB;
constexpr size_t WS_VA = 244 * MiB;
constexpr size_t WS_QR = 340 * MiB;
constexpr size_t WS_KR = 372 * MiB;
constexpr size_t WS_VR = 404 * MiB;
constexpr size_t WS_ATT = 468 * MiB;
constexpr size_t WS_END = 500 * MiB;
constexpr size_t WS_GR = WS_KA, WS_GA = WS_KA + 64 * MiB, WS_GT = WS_KA + 128 * MiB, WS_ACT = WS_KA, WS_T1 = WS_QA, WS_X1B = WS_QA, WS_MERGED = WS_QR;
constexpr int CW_TMO = 0, CW_CODE = 1, CW_BAR = 4096;

constexpr int RING_OFF = 0, RING_BYTES = 131072;
constexpr int LDSCTL_OFF = 139264, MISC_OFF = LDSCTL_OFF + 320;
constexpr int LDS_BYTES = 147456;

__device__ __forceinline__ float bf2f(bf16 v) { return __uint_as_float((unsigned)v << 16); }
__device__ __forceinline__ float wave_sum(float v) {
#pragma unroll
    for (int o = 1; o < 64; o <<= 1) v += __shfl_xor(v, o);
    return v;
}
__device__ __forceinline__ float ret_logg(int h) { return log1pf(-exp2f(-5.0f - (float)h)); }
__device__ __forceinline__ int kvidx(int dk, int dv) { const int dkl = dk & 31, hi = (dkl >> 2) & 1, rho = (dkl & 3) + 4 * (dkl >> 3); return (((dv >> 5) * 4 + (dk >> 5)) * 64 + (dv & 31) + 32 * hi) * 16 + rho; }

struct Frame {
    LAS unsigned char* lds; volatile LAS unsigned* MISC; gu32* ctl;
    int tid, lane, wave, G, gw, NGW;
    const float *x, *g_mix, *w_in, *w_oa, *w_or, *w_o, *g_ffn, *w_fg, *w_fu, *w_fd, *g_fin;
    float* out; unsigned char* ws;
};

__device__ __forceinline__ void p0_transpose_item(const float* W, int ldn, int K, int n0, int k0, bf16* WT, int dst_row0, const float* ks, LAS float* scr, int lane) {
#pragma unroll 8
    for (int i = 0; i < 32; ++i) { const int kk = 2 * i + (lane >> 5); float v = W[(size_t)(k0 + kk) * ldn + n0 + (lane & 31)]; if (ks) v *= ks[k0 + kk]; scr[kk * 33 + (lane & 31)] = v; }
    LDS_WAIT(); asm volatile("" ::: "memory");
    const int c = lane & 7;
#pragma unroll
    for (int j = 0; j < 4; ++j) { const int n = (lane >> 3) + 8 * j; const LAS float* s = scr + (8 * c) * 33 + n;
        v4u o; o.x = pk2(s[0 * 33], s[1 * 33]); o.y = pk2(s[2 * 33], s[3 * 33]); o.z = pk2(s[4 * 33], s[5 * 33]); o.w = pk2(s[6 * 33], s[7 * 33]);
        *(v4u*)(WT + (size_t)(dst_row0 + n) * K + k0 + 8 * c) = o; }
    LDS_WAIT(); asm volatile("" ::: "memory");
}
__device__ __forceinline__ void p0_prologue(Frame& F) {
    LAS float* scr = (LAS float*)(F.lds + RING_OFF + F.wave * 16384);
    bf16* WIN = (bf16*)(F.ws + WS_WIN); bf16* WOA = (bf16*)(F.ws + WS_WOA); bf16* WOR = (bf16*)(F.ws + WS_WOR); bf16* WO = (bf16*)(F.ws + WS_WO); bf16* WGU = (bf16*)(F.ws + WS_WGU); bf16* WD = (bf16*)(F.ws + WS_WD);
    constexpr int I0 = 16 * 304, I1 = 8 * 32, I2 = 16 * 32, I3 = 16 * 32, I4 = 16 * 176, I5 = 44 * 32, NITEMS = I0 + I1 + I2 + I3 + I4 + I5;
    for (int it = F.gw; it < NITEMS; it += F.NGW) {
        int r = it;
        if (r < I0) { const int kb = r / 304, G = r % 304; int sg = G;
            if (G < 96) { const int tile = G >> 3, j = G & 7; sg = tile * 8 + (j & 3) * 2 + (j >> 2); }
            p0_transpose_item(F.w_in, 9728, 1024, sg * 32, kb * 64, WIN, G * 32, nullptr, scr, F.lane); continue; } r -= I0;
        if (r < I1) { p0_transpose_item(F.w_oa, 1024, 512, (r % 32) * 32, (r / 32) * 64, WOA, (r % 32) * 32, nullptr, scr, F.lane); continue; } r -= I1;
        if (r < I2) { p0_transpose_item(F.w_or, 1024, 1024, (r % 32) * 32, (r / 32) * 64, WOR, (r % 32) * 32, nullptr, scr, F.lane); continue; } r -= I2;
        if (r < I3) { p0_transpose_item(F.w_o, 1024, 1024, (r % 32) * 32, (r / 32) * 64, WO, (r % 32) * 32, nullptr, scr, F.lane); continue; } r -= I3;
        if (r < I4) { const int kb = r / 176, G = r % 176, t = G >> 3, j = G & 7;
            p0_transpose_item(j < 4 ? F.w_fg : F.w_fu, FFH, 1024, (t * 4 + (j & 3)) * 32, kb * 64, WGU, G * 32, F.g_ffn, scr, F.lane); continue; } r -= I4;
        p0_transpose_item(F.w_fd, 1024, FFH, (r % 32) * 32, (r / 32) * 64, WD, (r % 32) * 32, nullptr, scr, F.lane);
    }
    float* rc = (float*)(F.ws + WS_ROPE); float* rs = rc + 4096 * 32; float* tc = (float*)(F.ws + WS_RETCS); float* ts = tc + 4096 * 64;
    const int gt = F.gw * 64 + F.lane, NGT = F.NGW * 64;
    for (int i = gt; i < 4096 * 32; i += NGT) { const int pos = i >> 5, k = i & 31; const float inv = powf(10000.0f, -(float)(2 * k) / 64.0f); const float ang = (float)pos * inv; rc[i] = cosf(ang); rs[i] = sinf(ang); }
    for (int i = gt; i < 4096 * 64; i += NGT) { const int pos = i >> 6, k = i & 63; const float ab = 1.0f / powf(10000.0f, (float)k / 63.0f); const float ang = (float)pos * ab; tc[i] = cosf(ang); ts[i] = sinf(ang); }
    bf16* XN = (bf16*)F.out;
    for (int m = F.gw; m < M; m += F.NGW) {
        const f32x4* xr = (const f32x4*)(F.x + (size_t)m * D) + F.lane; const f32x4* gr = (const f32x4*)F.g_mix + F.lane;
        f32x4 v[4]; float s = 0.f;
#pragma unroll
        for (int j = 0; j < 4; ++j) { v[j] = xr[64 * j]; s += (v[j].x * v[j].x + v[j].y * v[j].y) + (v[j].z * v[j].z + v[j].w * v[j].w); }
        const float rstd = 1.0f / sqrtf(wave_sum(s) * (1.f / D) + EPS);
        unsigned long long* o8 = (unsigned long long*)(XN + (size_t)m * D) + F.lane;
#pragma unroll
        for (int j = 0; j < 4; ++j) { const f32x4 g = gr[64 * j]; o8[64 * j] = (unsigned long long)pk2(v[j].x * rstd * g.x, v[j].y * rstd * g.y) | ((unsigned long long)pk2(v[j].z * rstd * g.z, v[j].w * rstd * g.w) << 32); }
    }
}

__device__ __forceinline__ void att_naive(Frame& F) {
    bf16* QA = (bf16*)(F.ws + WS_QA); const bf16* KA = (const bf16*)(F.ws + WS_KA); const bf16* VA = (const bf16*)(F.ws + WS_VA); float* LSE = (float*)(F.ws + WS_LSE);
    for (int item = F.gw; item < M * 24; item += F.NGW) {
        const int m = item / 24, hg = item % 24, g = hg >> 3, d = g == 0 ? 1 : (g == 1 ? 4 : 16), s = m & 4095;
        const size_t co = (size_t)hg * 64 + F.lane;
        const float q = bf2f(QA[(size_t)m * 1536 + co]);
        float mx = -1e30f, l = 0.f, o = 0.f;
        for (int j = 0; j <= 128; ++j) { if (s - j * d < 0) break; const size_t mk = (size_t)(m - j * d) * 1536 + co;
            const float sc = wave_sum(q * bf2f(KA[mk])) * 0.125f; const float mn = fmaxf(mx, sc), a = __expf(mx - mn), p = __expf(sc - mn);
            l = l * a + p; o = o * a + p * bf2f(VA[mk]); mx = mn; }
        QA[(size_t)m * 1536 + co] = (bf16)f2bf(o / l);
        if (F.lane == 0) LSE[(size_t)m * 24 + hg] = mx + __logf(l);
    }
}
__device__ __forceinline__ void att_merge(Frame& F) {
    const bf16* OG = (const bf16*)(F.ws + WS_QA); const float* LSE = (const float*)(F.ws + WS_LSE); bf16* ATT = (bf16*)(F.ws + WS_ATT);
    const int gt = F.gw * 64 + F.lane, NGT = F.NGW * 64;
    for (int it = gt; it < M * 64; it += NGT) { const int m = it >> 6, c = it & 63, head = c >> 3;
        const float l0 = LSE[(size_t)m * 24 + head], l1 = LSE[(size_t)m * 24 + 8 + head], l2 = LSE[(size_t)m * 24 + 16 + head];
        const float mx = fmaxf(l0, fmaxf(l1, l2)); float w0 = __expf(l0 - mx), w1 = __expf(l1 - mx), w2 = __expf(l2 - mx); const float inv = 1.0f / (w0 + w1 + w2); w0 *= inv; w1 *= inv; w2 *= inv;
        const v4u a = *(const v4u*)(OG + (size_t)m * 1536 + c * 8), b = *(const v4u*)(OG + (size_t)m * 1536 + 512 + c * 8), e = *(const v4u*)(OG + (size_t)m * 1536 + 1024 + c * 8);
        v4u o;
#define MRG(f) o.f = pk2(w0 * __uint_as_float(a.f << 16) + w1 * __uint_as_float(b.f << 16) + w2 * __uint_as_float(e.f << 16), w0 * __uint_as_float(a.f & 0xffff0000u) + w1 * __uint_as_float(b.f & 0xffff0000u) + w2 * __uint_as_float(e.f & 0xffff0000u))
        MRG(x); MRG(y); MRG(z); MRG(w);
#undef MRG
        *(v4u*)(ATT + (size_t)m * 512 + c * 8) = o; }
}
__device__ __forceinline__ void ret_kv_naive(Frame& F) {
    const bf16* KR = (const bf16*)(F.ws + WS_KR); const bf16* VR = (const bf16*)(F.ws + WS_VR); bf16* KVS = (bf16*)((unsigned char*)F.out + 64 * MiB);
    const int gt = F.gw * 64 + F.lane, NGT = F.NGW * 64;
    for (long it = gt; it < 1024l * 32768l; it += NGT) { const int unit = (int)(it >> 15), e = (int)(it & 32767), dv = e & 255, dk = e >> 8;
        const int bh = unit >> 5, n = unit & 31, b = bh >> 2, h = bh & 3; const size_t row0 = (size_t)b * SEQ + n * 128; const float lg = ret_logg(h);
        float acc = 0.f;
        for (int j = 0; j < 128; ++j) acc += __expf((float)(127 - j) * lg) * bf2f(KR[(row0 + j) * 512 + h * 128 + dk]) * bf2f(VR[(row0 + j) * 1024 + h * 256 + dv]);
        KVS[(size_t)unit * 32768 + kvidx(dk, dv)] = (bf16)f2bf(acc); }
}
__device__ __forceinline__ void ret_scan(Frame& F) {
    bf16* KVS = (bf16*)((unsigned char*)F.out + 64 * MiB);
    const int gt = F.gw * 64 + F.lane, NGT = F.NGW * 64;
    for (int t = gt; t < 32 * 4096; t += NGT) { const int bh = t >> 12, e8 = t & 4095, h = bh & 3; const float cd = __expf(128.0f * ret_logg(h));
        float r[8];
#pragma unroll
        for (int i = 0; i < 8; ++i) r[i] = 0.f;
        v4u* p = (v4u*)(KVS + (size_t)bh * 32 * 32768 + (size_t)e8 * 8);
#pragma unroll 4
        for (int n = 0; n < 32; ++n) { const v4u kv = p[(size_t)n * 4096]; v4u o; o.x = pk2(r[0], r[1]); o.y = pk2(r[2], r[3]); o.z = pk2(r[4], r[5]); o.w = pk2(r[6], r[7]); p[(size_t)n * 4096] = o;
            r[0] = r[0] * cd + __uint_as_float(kv.x << 16); r[1] = r[1] * cd + __uint_as_float(kv.x & 0xffff0000u); r[2] = r[2] * cd + __uint_as_float(kv.y << 16); r[3] = r[3] * cd + __uint_as_float(kv.y & 0xffff0000u);
            r[4] = r[4] * cd + __uint_as_float(kv.z << 16); r[5] = r[5] * cd + __uint_as_float(kv.z & 0xffff0000u); r[6] = r[6] * cd + __uint_as_float(kv.w << 16); r[7] = r[7] * cd + __uint_as_float(kv.w & 0xffff0000u); } }
}
__device__ __forceinline__ void ret_out_naive(Frame& F) {
    const bf16* QR = (const bf16*)(F.ws + WS_QR); const bf16* KR = (const bf16*)(F.ws + WS_KR); const bf16* VR = (const bf16*)(F.ws + WS_VR); const bf16* GR = (const bf16*)(F.ws + WS_GR);
    const bf16* KVS = (const bf16*)((unsigned char*)F.out + 64 * MiB); bf16* RET = (bf16*)F.out;
    for (int item = F.gw; item < M * 4; item += F.NGW) { const int m = item >> 2, h = item & 3, i = m & 127, n = (m & 4095) >> 7, b = m >> 12; const size_t row0 = (size_t)m - i; const float lg = ret_logg(h);
        const float q0 = bf2f(QR[(size_t)m * 512 + h * 128 + F.lane]), q1 = bf2f(QR[(size_t)m * 512 + h * 128 + 64 + F.lane]);
        float o0 = 0.f, o1 = 0.f, o2 = 0.f, o3 = 0.f;
        for (int j = 0; j <= i; ++j) { const bf16* kp = KR + (row0 + j) * 512 + h * 128 + F.lane; const float s = wave_sum(q0 * bf2f(kp[0]) + q1 * bf2f(kp[64])) * __expf((float)(i - j) * lg);
            const bf16* vp = VR + (row0 + j) * 1024 + h * 256 + F.lane; o0 += s * bf2f(vp[0]); o1 += s * bf2f(vp[64]); o2 += s * bf2f(vp[128]); o3 += s * bf2f(vp[192]); }
        const bf16* R = KVS + (size_t)((b * 4 + h) * 32 + n) * 32768; const float xi = __expf((float)(i + 1) * lg);
        float c0 = 0.f, c1 = 0.f, c2 = 0.f, c3 = 0.f;
        for (int dk = 0; dk < 128; ++dk) { const float qd = dk < 64 ? __shfl(q0, dk) : __shfl(q1, dk - 64);
            c0 += qd * bf2f(R[kvidx(dk, F.lane)]); c1 += qd * bf2f(R[kvidx(dk, F.lane + 64)]); c2 += qd * bf2f(R[kvidx(dk, F.lane + 128)]); c3 += qd * bf2f(R[kvidx(dk, F.lane + 192)]); }
        o0 += xi * c0; o1 += xi * c1; o2 += xi * c2; o3 += xi * c3;
        const float mu = wave_sum((o0 + o1) + (o2 + o3)) * (1.0f / 256.0f); o0 -= mu; o1 -= mu; o2 -= mu; o3 -= mu;
        const float var = wave_sum((o0 * o0 + o1 * o1) + (o2 * o2 + o3 * o3)) * (1.0f / 256.0f), rs = 1.0f / sqrtf(var + EPS);
        const bf16* gp = GR + (size_t)m * 1024 + h * 256 + F.lane; bf16* op = RET + (size_t)m * 1024 + h * 256 + F.lane;
        op[0] = (bf16)f2bf(o0 * rs * bf2f(gp[0])); op[64] = (bf16)f2bf(o1 * rs * bf2f(gp[64])); op[128] = (bf16)f2bf(o2 * rs * bf2f(gp[128])); op[192] = (bf16)f2bf(o3 * rs * bf2f(gp[192])); }
}
__device__ __forceinline__ void final_norm(Frame& F) {
    const float* SSQ = (const float*)(F.ws + WS_SSQ2);
    for (int m = F.gw; m < M; m += F.NGW) { const f32x4* sp = (const f32x4*)(SSQ + (size_t)m * 16); const f32x4 q = (sp[0] + sp[1]) + (sp[2] + sp[3]);
        const float rstd = 1.0f / sqrtf(((q[0] + q[1]) + (q[2] + q[3])) * (1.f / D) + EPS);
        f32x4* xr = (f32x4*)(F.out + (size_t)m * D) + F.lane; const f32x4* gr = (const f32x4*)F.g_fin + F.lane;
#pragma unroll
        for (int j = 0; j < 4; ++j) xr[64 * j] = xr[64 * j] * rstd * gr[64 * j]; }
}


namespace att {
typedef float f32x16 __attribute__((ext_vector_type(16)));
typedef short s16x4 __attribute__((ext_vector_type(4)));
typedef short v4i16_t __attribute__((ext_vector_type(4)));
constexpr int KCH = 6160;
constexpr int L_K = 0, L_V = 8 * KCH, L_WS = L_V + 6 * 8192, L_OST = L_WS + 8 * 256, L_END = L_OST + 8 * 4096;
constexpr float C2 = 0.125f * 1.4426950408889634f;
__device__ __forceinline__ int crow(int r, int hi) { return (r & 3) + 8 * (r >> 2) + 4 * hi; }
__device__ __forceinline__ unsigned cvtpk(float lo, float hi) { typedef float f2_ __attribute__((ext_vector_type(2))); typedef __bf16 b2_ __attribute__((ext_vector_type(2))); const f2_ v = {lo, hi}; return __builtin_bit_cast(unsigned, __builtin_convertvector(v, b2_)); }
__device__ __forceinline__ float swapmax(float m) { auto rr = __builtin_amdgcn_permlane32_swap(__float_as_uint(m), __float_as_uint(m), false, false); return fmaxf(__uint_as_float(rr[0]), __uint_as_float(rr[1])); }
__device__ __forceinline__ float swapsum(float m) { auto rr = __builtin_amdgcn_permlane32_swap(__float_as_uint(m), __float_as_uint(m), false, false); return __uint_as_float(rr[0]) + __uint_as_float(rr[1]); }
__device__ __forceinline__ s16x4 vtr(const LAS unsigned char* p) { return __builtin_bit_cast(s16x4, __builtin_amdgcn_ds_read_tr16_b64_v4i16((LAS v4i16_t*)p)); }

__device__ __forceinline__ void att_unit(LAS unsigned char* lds, bf16* QO, const bf16* KA, const bf16* VA, float* LSE, int U) {
    const int tid = threadIdx.x, lane = tid & 63, r32 = lane & 31, hi = lane >> 5, w = __builtin_amdgcn_readfirstlane(tid >> 6);
    const int u16 = U & 15, head = (U >> 4) & 7, g = (U >> 7) % 3, b = U / 384;
    const int ld = g == 0 ? 0 : (g == 1 ? 2 : 4), d = 1 << ld, r = u16 & (d - 1), blk = u16 >> ld;
    const int hg = g * 8 + head, colofs = hg * 64; const size_t rowbase = (size_t)b * SEQ;
    const int i0 = blk * 256, k0 = i0 - 128;
    v4u kreg[6], vreg[6];
#pragma unroll
    for (int it = 0; it < 6; ++it) { const int item = tid + 512 * it, row = item >> 3, c = item & 7, ik = k0 + row;
        if (ik >= 0) { const size_t ga = (rowbase + (size_t)ik * d + r) * 1536 + colofs + c * 8; kreg[it] = *(const v4u*)(KA + ga); vreg[it] = *(const v4u*)(VA + ga); }
        else { kreg[it] = (v4u){0u, 0u, 0u, 0u}; vreg[it] = (v4u){0u, 0u, 0u, 0u}; } }
    const int iq = i0 + 32 * w + r32; const size_t qrow = rowbase + (size_t)iq * d + r;
    bf16x8 qr[4];
#pragma unroll
    for (int d0 = 0; d0 < 4; ++d0) qr[d0] = *(const bf16x8*)(QO + qrow * 1536 + colofs + d0 * 16 + hi * 8);
#pragma unroll
    for (int it = 0; it < 6; ++it) { const int item = tid + 512 * it, row = item >> 3, c = item & 7;
        *(LAS v4u*)(lds + L_K + c * KCH + row * 16) = kreg[it];
        *(LAS v4u*)(lds + L_V + (row >> 6) * 8192 + (c >> 2) * 4096 + ((row >> 4) & 3) * 1024 + (row & 15) * 64 + (c & 3) * 16) = vreg[it]; }
    __syncthreads();
    const bool first = (blk == 0);
    f32x16 p[5];
#pragma unroll
    for (int jb = 0; jb < 5; ++jb) {
        const int W = w + jb;
        if (first && W < 4) {
#pragma unroll
            for (int q = 0; q < 16; ++q) p[jb][q] = -INFINITY;
        } else {
            f32x16 a = {};
#pragma unroll
            for (int d0 = 0; d0 < 4; ++d0) { const bf16x8 kf = *(const LAS bf16x8*)(lds + L_K + (2 * d0 + hi) * KCH + (32 * W + r32) * 16); a = __builtin_amdgcn_mfma_f32_32x32x16_bf16(kf, qr[d0], a, 0, 0, 0); }
            p[jb] = a;
        }
    }
#pragma unroll
    for (int q = 0; q < 16; ++q) { const int kr = crow(q, hi); if (kr < r32) p[0][q] = -INFINITY; if (kr > r32) p[4][q] = -INFINITY; }
    float mx = -INFINITY;
#pragma unroll
    for (int jb = 0; jb < 5; ++jb)
#pragma unroll
        for (int q = 0; q < 16; ++q) mx = fmaxf(mx, p[jb][q]);
    mx = swapmax(mx);
    const float mc = mx * C2; float l = 0.f;
#pragma unroll
    for (int jb = 0; jb < 5; ++jb)
#pragma unroll
        for (int q = 0; q < 16; ++q) { const float e = __builtin_amdgcn_exp2f(p[jb][q] * C2 - mc); p[jb][q] = e; l += e; }
    l = swapsum(l);
    f32x16 o[2]; o[0] = f32x16{}; o[1] = f32x16{};
    const int vb = ((lane >> 4) & 1) * 32 + (lane & 3) * 8 + (4 * hi + ((lane & 15) >> 2)) * 64;
#pragma unroll
    for (int jb = 0; jb < 5; ++jb) {
        const int W = w + jb;
        if (!(first && W < 4)) {
#pragma unroll
            for (int s = 0; s < 2; ++s) {
                v4u pw; pw.x = cvtpk(p[jb][8 * s + 0], p[jb][8 * s + 1]); pw.y = cvtpk(p[jb][8 * s + 2], p[jb][8 * s + 3]); pw.z = cvtpk(p[jb][8 * s + 4], p[jb][8 * s + 5]); pw.w = cvtpk(p[jb][8 * s + 6], p[jb][8 * s + 7]);
                const bf16x8 pa = __builtin_bit_cast(bf16x8, pw);
                const LAS unsigned char* vp = lds + L_V + (W >> 1) * 8192 + ((W & 1) * 2 + s) * 1024 + vb;
#pragma unroll
                for (int d0 = 0; d0 < 2; ++d0) { const s16x4 lo = vtr(vp + d0 * 4096), hh = vtr(vp + d0 * 4096 + 512);
                    const bf16x8 vf = (bf16x8){lo[0], lo[1], lo[2], lo[3], hh[0], hh[1], hh[2], hh[3]};
                    o[d0] = __builtin_amdgcn_mfma_f32_32x32x16_bf16(pa, vf, o[d0], 0, 0, 0); }
            }
        }
    }
    LAS float* wsf = (LAS float*)(lds + L_WS) + w * 64;
    if (hi == 0) { wsf[r32] = l; LSE[(qrow) * 24 + hg] = mx * 0.125f + __logf(l); }
    LDS_WAIT();
    LAS bf16* stg = (LAS bf16*)(lds + L_OST) + w * 2048;
#pragma unroll
    for (int q = 0; q < 16; ++q) { const int orow = crow(q, hi); const float rl = __builtin_amdgcn_rcpf(wsf[orow]);
        stg[orow * 64 + r32] = (bf16)f2bf(o[0][q] * rl); stg[orow * 64 + 32 + r32] = (bf16)f2bf(o[1][q] * rl); }
    LDS_WAIT();
    const size_t orow0 = rowbase + (size_t)(i0 + 32 * w) * d + r;
#pragma unroll
    for (int i = 0; i < 4; ++i) { const int row = i * 8 + (lane >> 3), ch = lane & 7; const v4u v = *(const LAS v4u*)(stg + row * 64 + ch * 8); *(v4u*)(QO + (orow0 + (size_t)row * d) * 1536 + colofs + ch * 8) = v; }
    __syncthreads();
}
__device__ __forceinline__ void att_phase(Frame& F) {
    bf16* QA = (bf16*)(F.ws + WS_QA); const bf16* KA = (const bf16*)(F.ws + WS_KA); const bf16* VA = (const bf16*)(F.ws + WS_VA); float* LSE = (float*)(F.ws + WS_LSE);
    for (int U = (int)blockIdx.x; U < 3072; U += F.G) att_unit(F.lds, QA, KA, VA, LSE, U);
}
}


namespace ret {
typedef float f32x16 __attribute__((ext_vector_type(16)));
typedef short s16x4 __attribute__((ext_vector_type(4)));
typedef short v4i16_t __attribute__((ext_vector_type(4)));
typedef unsigned v2u __attribute__((ext_vector_type(2)));
__device__ __forceinline__ int crow(int r, int hi) { return (r & 3) + 8 * (r >> 2) + 4 * hi; }
__device__ __forceinline__ unsigned cvtpk(float lo, float hi) { typedef float f2_ __attribute__((ext_vector_type(2))); typedef __bf16 b2_ __attribute__((ext_vector_type(2))); const f2_ v = {lo, hi}; return __builtin_bit_cast(unsigned, __builtin_convertvector(v, b2_)); }
__device__ __forceinline__ float swapsum(float m) { auto rr = __builtin_amdgcn_permlane32_swap(__float_as_uint(m), __float_as_uint(m), false, false); return __uint_as_float(rr[0]) + __uint_as_float(rr[1]); }
__device__ __forceinline__ s16x4 vtr(const LAS unsigned char* p) { return __builtin_bit_cast(s16x4, __builtin_amdgcn_ds_read_tr16_b64_v4i16((LAS v4i16_t*)p)); }
__device__ __forceinline__ bf16x8 trfrag(const LAS unsigned char* p) { const s16x4 lo = vtr(p), hh = vtr(p + 512); return (bf16x8){lo[0], lo[1], lo[2], lo[3], hh[0], hh[1], hh[2], hh[3]}; }
__device__ __forceinline__ int img_off(int key, int c) { return (c >> 2) * 8192 + (key >> 4) * 1024 + (key & 15) * 64 + (c & 3) * 16; }
__device__ __forceinline__ v4u scale8(v4u v, float s) { v4u o;
    o.x = pk2(__uint_as_float(v.x << 16) * s, __uint_as_float(v.x & 0xffff0000u) * s); o.y = pk2(__uint_as_float(v.y << 16) * s, __uint_as_float(v.y & 0xffff0000u) * s);
    o.z = pk2(__uint_as_float(v.z << 16) * s, __uint_as_float(v.z & 0xffff0000u) * s); o.w = pk2(__uint_as_float(v.w << 16) * s, __uint_as_float(v.w & 0xffff0000u) * s); return o; }

constexpr int KV_LK = 0, KV_LV = 32768;
__device__ __forceinline__ void kv_unit(LAS unsigned char* lds, const bf16* KR, const bf16* VR, bf16* KVS, int unit) {
    const int tid = threadIdx.x, lane = tid & 63, hi = lane >> 5, w = __builtin_amdgcn_readfirstlane(tid >> 6);
    const int bh = unit >> 5, n = unit & 31, b = bh >> 2, h = bh & 3; const size_t row0 = (size_t)b * SEQ + n * 128; const float lg2 = ret_logg(h) * 1.4426950408889634f;
    v4u kreg[4], vreg[8];
#pragma unroll
    for (int it = 0; it < 4; ++it) { const int item = tid + 512 * it, row = item >> 4, c = item & 15; kreg[it] = *(const v4u*)(KR + (row0 + row) * 512 + h * 128 + c * 8); }
#pragma unroll
    for (int it = 0; it < 8; ++it) { const int item = tid + 512 * it, row = item >> 5, c = item & 31; vreg[it] = *(const v4u*)(VR + (row0 + row) * 1024 + h * 256 + c * 8); }
#pragma unroll
    for (int it = 0; it < 4; ++it) { const int item = tid + 512 * it, row = item >> 4, c = item & 15; *(LAS v4u*)(lds + KV_LK + img_off(row, c)) = scale8(kreg[it], __builtin_amdgcn_exp2f((float)(127 - row) * lg2)); }
#pragma unroll
    for (int it = 0; it < 8; ++it) { const int item = tid + 512 * it, row = item >> 5, c = item & 31; *(LAS v4u*)(lds + KV_LV + img_off(row, c)) = vreg[it]; }
    __syncthreads();
    const int mb = w & 3, nb0 = (w >> 2) * 4;
    const int vb = ((lane >> 4) & 1) * 32 + (lane & 3) * 8 + (4 * hi + ((lane & 15) >> 2)) * 64;
    f32x16 acc[4]; acc[0] = f32x16{}; acc[1] = f32x16{}; acc[2] = f32x16{}; acc[3] = f32x16{};
#pragma unroll
    for (int ks = 0; ks < 8; ++ks) { const bf16x8 af = trfrag(lds + KV_LK + mb * 8192 + ks * 1024 + vb);
#pragma unroll
        for (int t = 0; t < 4; ++t) { const bf16x8 bfr = trfrag(lds + KV_LV + (nb0 + t) * 8192 + ks * 1024 + vb); acc[t] = __builtin_amdgcn_mfma_f32_32x32x16_bf16(af, bfr, acc[t], 0, 0, 0); } }
    bf16* out = KVS + (size_t)unit * 32768;
#pragma unroll
    for (int t = 0; t < 4; ++t) { v4u o0, o1;
        o0.x = cvtpk(acc[t][0], acc[t][1]); o0.y = cvtpk(acc[t][2], acc[t][3]); o0.z = cvtpk(acc[t][4], acc[t][5]); o0.w = cvtpk(acc[t][6], acc[t][7]);
        o1.x = cvtpk(acc[t][8], acc[t][9]); o1.y = cvtpk(acc[t][10], acc[t][11]); o1.z = cvtpk(acc[t][12], acc[t][13]); o1.w = cvtpk(acc[t][14], acc[t][15]);
        v4u* op = (v4u*)(out + (((nb0 + t) * 4 + mb) * 64 + lane) * 16); op[0] = o0; op[1] = o1; }
    __syncthreads();
}
__device__ __forceinline__ void kv_phase(Frame& F) {
    const bf16* KR = (const bf16*)(F.ws + WS_KR); const bf16* VR = (const bf16*)(F.ws + WS_VR); bf16* KVS = (bf16*)((unsigned char*)F.out + 64 * MiB);
    for (int u = (int)blockIdx.x; u < 1024; u += F.G) kv_unit(F.lds, KR, VR, KVS, u);
}

constexpr int O_KCH = 2064, O_LK = 0, O_LV = 16 * O_KCH, O_LST = O_LV + 65536;
__device__ __forceinline__ void out_unit(LAS unsigned char* lds, const bf16* QR, const bf16* KR, const bf16* VR, const bf16* GR, const bf16* KVS, bf16* RET, int unit) {
    const int tid = threadIdx.x, lane = tid & 63, r32 = lane & 31, hi = lane >> 5, w = __builtin_amdgcn_readfirstlane(tid >> 6);
    const int bh = unit >> 5, n = unit & 31, b = bh >> 2, h = bh & 3; const size_t row0 = (size_t)b * SEQ + n * 128; const float lg2 = ret_logg(h) * 1.4426950408889634f;
    const int qb = w & 3, dvh = w >> 2;
    v4u kreg[4], vreg[8];
#pragma unroll
    for (int it = 0; it < 4; ++it) { const int item = tid + 512 * it, row = item >> 4, c = item & 15; kreg[it] = *(const v4u*)(KR + (row0 + row) * 512 + h * 128 + c * 8); }
#pragma unroll
    for (int it = 0; it < 8; ++it) { const int item = tid + 512 * it, row = item >> 5, c = item & 31; vreg[it] = *(const v4u*)(VR + (row0 + row) * 1024 + h * 256 + c * 8); }
    const int iq = 32 * qb + r32; const size_t qrow = row0 + iq; const bf16* qp = QR + qrow * 512 + h * 128;
    f32x16 acc[4]; acc[0] = f32x16{}; acc[1] = f32x16{}; acc[2] = f32x16{}; acc[3] = f32x16{};
    const bf16* Rb = KVS + (size_t)unit * 32768;
#pragma unroll
    for (int S = 0; S < 4; ++S)
#pragma unroll
        for (int s1 = 0; s1 < 2; ++s1) {
            const v2u qa = *(const v2u*)(qp + 32 * S + 16 * s1 + 4 * hi), qc = *(const v2u*)(qp + 32 * S + 16 * s1 + 8 + 4 * hi);
            const bf16x8 qf = __builtin_bit_cast(bf16x8, (v4u){qa.x, qa.y, qc.x, qc.y});
#pragma unroll
            for (int t = 0; t < 4; ++t) { const bf16x8 rf = *(const bf16x8*)(Rb + ((((dvh * 4 + t) * 4 + S) * 64 + lane) * 16 + s1 * 8)); acc[t] = __builtin_amdgcn_mfma_f32_32x32x16_bf16(rf, qf, acc[t], 0, 0, 0); }
        }
    const float xi = __builtin_amdgcn_exp2f((float)(iq + 1) * lg2);
#pragma unroll
    for (int t = 0; t < 4; ++t) acc[t] = acc[t] * xi;
#pragma unroll
    for (int it = 0; it < 4; ++it) { const int item = tid + 512 * it, row = item >> 4, c = item & 15; *(LAS v4u*)(lds + O_LK + c * O_KCH + row * 16) = kreg[it]; }
#pragma unroll
    for (int it = 0; it < 8; ++it) { const int item = tid + 512 * it, row = item >> 5, c = item & 31; *(LAS v4u*)(lds + O_LV + img_off(row, c)) = vreg[it]; }
    bf16x8 qn[8];
#pragma unroll
    for (int s = 0; s < 8; ++s) qn[s] = *(const bf16x8*)(qp + 16 * s + 8 * hi);
    __syncthreads();
    const int vb = ((lane >> 4) & 1) * 32 + (lane & 3) * 8 + (4 * hi + ((lane & 15) >> 2)) * 64;
#pragma unroll
    for (int kb = 0; kb < 4; ++kb) {
        if (kb <= qb) {
            f32x16 p = {};
#pragma unroll
            for (int s = 0; s < 8; ++s) { const bf16x8 kf = *(const LAS bf16x8*)(lds + O_LK + (2 * s + hi) * O_KCH + (32 * kb + r32) * 16); p = __builtin_amdgcn_mfma_f32_32x32x16_bf16(kf, qn[s], p, 0, 0, 0); }
#pragma unroll
            for (int q = 0; q < 16; ++q) { const int dist = iq - (32 * kb + crow(q, hi)); p[q] = dist >= 0 ? p[q] * __builtin_amdgcn_exp2f((float)dist * lg2) : 0.f; }
#pragma unroll
            for (int s = 0; s < 2; ++s) {
                v4u pw; pw.x = cvtpk(p[8 * s + 0], p[8 * s + 1]); pw.y = cvtpk(p[8 * s + 2], p[8 * s + 3]); pw.z = cvtpk(p[8 * s + 4], p[8 * s + 5]); pw.w = cvtpk(p[8 * s + 6], p[8 * s + 7]);
                const bf16x8 pb = __builtin_bit_cast(bf16x8, pw);
#pragma unroll
                for (int t = 0; t < 4; ++t) { const bf16x8 vf = trfrag(lds + O_LV + (dvh * 4 + t) * 8192 + (2 * kb + s) * 1024 + vb); acc[t] = __builtin_amdgcn_mfma_f32_32x32x16_bf16(vf, pb, acc[t], 0, 0, 0); }
            }
        }
    }
    float s1 = 0.f, s2 = 0.f;
#pragma unroll
    for (int t = 0; t < 4; ++t)
#pragma unroll
        for (int q = 0; q < 16; ++q) { s1 += acc[t][q]; s2 += acc[t][q] * acc[t][q]; }
    s1 = swapsum(s1); s2 = swapsum(s2);
    LAS float* st = (LAS float*)(lds + O_LST);
    if (hi == 0) { st[(iq * 2 + dvh) * 2] = s1; st[(iq * 2 + dvh) * 2 + 1] = s2; }
    __syncthreads();
    const float t1 = st[iq * 4] + st[iq * 4 + 2], t2 = st[iq * 4 + 1] + st[iq * 4 + 3];
    const float mu = t1 * (1.0f / 256.0f), var = fmaxf(t2 * (1.0f / 256.0f) - mu * mu, 0.f), rs = __builtin_amdgcn_rsqf(var + EPS);
    const bf16* gp = GR + qrow * 1024 + h * 256 + dvh * 128; bf16* op = RET + qrow * 1024 + h * 256 + dvh * 128;
#pragma unroll
    for (int t = 0; t < 4; ++t)
#pragma unroll
        for (int q4 = 0; q4 < 4; ++q4) { const int dv = 32 * t + 8 * q4 + 4 * hi; const v2u g = *(const v2u*)(gp + dv);
            const float y0 = (acc[t][4 * q4 + 0] - mu) * rs * __uint_as_float(g.x << 16), y1 = (acc[t][4 * q4 + 1] - mu) * rs * __uint_as_float(g.x & 0xffff0000u);
            const float y2 = (acc[t][4 * q4 + 2] - mu) * rs * __uint_as_float(g.y << 16), y3 = (acc[t][4 * q4 + 3] - mu) * rs * __uint_as_float(g.y & 0xffff0000u);
            v2u o; o.x = cvtpk(y0, y1); o.y = cvtpk(y2, y3); *(v2u*)(op + dv) = o; }
    __syncthreads();
}
__device__ __forceinline__ void out_phase(Frame& F) {
    const bf16* QR = (const bf16*)(F.ws + WS_QR); const bf16* KR = (const bf16*)(F.ws + WS_KR); const bf16* VR = (const bf16*)(F.ws + WS_VR); const bf16* GR = (const bf16*)(F.ws + WS_GR);
    const bf16* KVS = (const bf16*)((unsigned char*)F.out + 64 * MiB); bf16* RET = (bf16*)F.out;
    for (int u = (int)blockIdx.x; u < 1024; u += F.G) out_unit(F.lds, QR, KR, VR, GR, KVS, RET, u);
}
}

struct Args { const float* in[11]; float* out; unsigned char* ws; int ph_lo, ph_hi, li, pad; };
__global__ void __launch_bounds__(NWAVES * 64, 2) mega_fwd(Args args) {
    extern __shared__ __attribute__((aligned(16))) unsigned char lds[];
    Frame F;
    F.lds = (LAS unsigned char*)lds; F.MISC = (volatile LAS unsigned*)(F.lds + MISC_OFF);
    F.tid = threadIdx.x; F.lane = F.tid & 63; F.wave = __builtin_amdgcn_readfirstlane(F.tid >> 6);
    F.G = gridDim.x; F.gw = (int)blockIdx.x * NWAVES + F.wave; F.NGW = F.G * NWAVES;
    F.ws = args.ws; F.ctl = (gu32*)(args.ws + WS_CTL); F.out = args.out;
    F.x = args.in[0]; F.g_mix = args.in[1]; F.w_in = args.in[2]; F.w_oa = args.in[3]; F.w_or = args.in[4]; F.w_o = args.in[5]; F.g_ffn = args.in[6]; F.w_fg = args.in[7]; F.w_fu = args.in[8]; F.w_fd = args.in[9]; F.g_fin = args.in[10];
    for (int u = F.tid; u < (LDS_BYTES - LDSCTL_OFF) / 4; u += NWAVES * 64) ((LAS unsigned*)(F.lds + LDSCTL_OFF))[u] = 0u;
    __syncthreads();
    XcdBarrier bar; bar.bar = (unsigned*)(F.ctl + CW_BAR); bar.x = 0; bar.st = nullptr;
    if (ONE_LAUNCH) bar = xcd_barrier_post((unsigned*)(F.ctl + CW_BAR), F.MISC + 8);
    const int lo = args.ph_lo, hi = args.ph_hi;
#define IN(k) (lo <= (k) && (k) < hi)
#define SEAM(k) do { if (IN(k) && IN((k) + 1)) xcd_barrier(bar); } while (0)
    typedef pg8::bf16_t pb;
    pb* const XN = (pb*)F.out; pb* const RET = (pb*)F.out;
    pb* const WIN = (pb*)(F.ws + WS_WIN);

    if (IN(0)) { p0_prologue(F); } SEAM(0);

    if (IN(1)) {
        pg8::Gemm g{XN, WIN, M, NQKV_A, D}; pg8::StaticOrder S; S.init(M, NQKV_A, F.G, (int)blockIdx.x);
        const float* rc = (const float*)(F.ws + WS_ROPE); const float* tc = (const float*)(F.ws + WS_RETCS);
        pg8::EpiProjA E{(pb*)(F.ws + WS_QA), (pb*)(F.ws + WS_KA), (pb*)(F.ws + WS_VA), (pb*)(F.ws + WS_QR), (pb*)(F.ws + WS_KR), (pb*)(F.ws + WS_VR), rc, rc + 4096 * 32, tc, tc + 4096 * 64};
        pg8::gemm_phase<pg8::EpiProjA, pg8::StaticOrder, true, true>(F.lds + RING_OFF, g, S, E);
    } SEAM(1);

    if (IN(2)) {
#if NAIVE_ATT
        att_naive(F);
#else
        att::att_phase(F);
#endif
#if NAIVE_RET
        ret_kv_naive(F);
#else
        ret::kv_phase(F);
#endif
    } SEAM(2);

    if (IN(3)) {
        ret_scan(F);
        pg8::Gemm g{XN, WIN + (size_t)NQKV_A * D, M, NGATES, D}; pg8::StaticOrder S; S.init(M, NGATES, F.G, (int)blockIdx.x);
        pg8::EpiGates E{(pb*)(F.ws + WS_GR), (size_t)(WS_GA - WS_GR) / 2};
        pg8::gemm_phase<pg8::EpiGates, pg8::StaticOrder, true, true>(F.lds + RING_OFF, g, S, E);
    } SEAM(3);

    if (IN(4)) {
#if NAIVE_RET
        ret_out_naive(F);
#else
        ret::out_phase(F);
#endif
        att_merge(F);
    } SEAM(4);

    if (IN(5)) {
        { pg8::Gemm g{(pb*)(F.ws + WS_ATT), (pb*)(F.ws + WS_WOA), M, D, 512}; pg8::StaticOrder S; S.init(M, D, F.G, (int)blockIdx.x);
          pg8::EpiGateMul<false> E{(pb*)(F.ws + WS_GA), nullptr, (pb*)(F.ws + WS_T1)};
          pg8::gemm_phase<pg8::EpiGateMul<false>, pg8::StaticOrder, true, true>(F.lds + RING_OFF, g, S, E); }
        VM_WAIT(); __syncthreads();
        { pg8::Gemm g{RET, (pb*)(F.ws + WS_WOR), M, D, D}; pg8::StaticOrder S; S.init(M, D, F.G, (int)blockIdx.x);
          pg8::EpiGateMul<true> E{(pb*)(F.ws + WS_GT), (pb*)(F.ws + WS_T1), (pb*)(F.ws + WS_MERGED)};
          pg8::gemm_phase<pg8::EpiGateMul<true>, pg8::StaticOrder, true, true>(F.lds + RING_OFF, g, S, E); }
    } SEAM(5);

    if (IN(6)) {
        pg8::Gemm g{(pb*)(F.ws + WS_MERGED), (pb*)(F.ws + WS_WO), M, D, D}; pg8::StaticOrder S; S.init(M, D, F.G, (int)blockIdx.x);
        pg8::EpiResid E{F.x, F.out, (pb*)(F.ws + WS_X1B), (float*)(F.ws + WS_SSQ1)};
        pg8::gemm_phase<pg8::EpiResid, pg8::StaticOrder, true, true>(F.lds + RING_OFF, g, S, E);
    } SEAM(6);

    if (IN(7)) {
        pg8::Gemm g{(pb*)(F.ws + WS_X1B), (pb*)(F.ws + WS_WGU), M, 2 * FFH, D}; pg8::StaticOrder S; S.init(M, 2 * FFH, F.G, (int)blockIdx.x);
        pg8::EpiFfnAct E{(const float*)(F.ws + WS_SSQ1), (pb*)(F.ws + WS_ACT)};
        pg8::gemm_phase<pg8::EpiFfnAct, pg8::StaticOrder, true, true>(F.lds + RING_OFF, g, S, E);
    } SEAM(7);

    if (IN(8)) {
        pg8::Gemm g{(pb*)(F.ws + WS_ACT), (pb*)(F.ws + WS_WD), M, D, FFH}; pg8::StaticOrder S; S.init(M, D, F.G, (int)blockIdx.x);
        pg8::EpiResid E{F.out, F.out, nullptr, (float*)(F.ws + WS_SSQ2)};
        pg8::gemm_phase<pg8::EpiResid, pg8::StaticOrder, true, true>(F.lds + RING_OFF, g, S, E);
    } SEAM(8);

    if (IN(9)) { final_norm(F); }
#undef IN
#undef SEAM
}

extern "C" void kernel_launch(void* const* d_in, const int* in_sizes, int n_in, void* d_out, int out_size, void* d_ws, size_t ws_size, hipStream_t stream) {
    static int grid = 0;
    if (grid == 0) {
        if (n_in != 11 || in_sizes[0] != M * D || out_size != M * D || ws_size < WS_END) { fprintf(stderr, "kernel_launch: unexpected shapes / workspace (n_in %d, in0 %d, out %d, ws %zu)\n", n_in, n_in > 0 ? in_sizes[0] : -1, out_size, ws_size); grid = -1; return; }
        int dev = 0, cus = 0;
        if (hipGetDevice(&dev) != hipSuccess || hipDeviceGetAttribute(&cus, hipDeviceAttributeMultiprocessorCount, dev) != hipSuccess) { grid = -1; return; }
        if (hipFuncSetAttribute((const void*)mega_fwd, hipFuncAttributeMaxDynamicSharedMemorySize, LDS_BYTES) != hipSuccess) { fprintf(stderr, "kernel_launch: hipFuncSetAttribute failed\n"); grid = -1; return; }
        (void)hipGetLastError();
        grid = cus;
    }
    if (grid < 0) return;
    if (hipMemsetAsync((char*)d_ws + WS_CTL, 0, CTL_ZERO_BYTES, stream) != hipSuccess) return;
    Args a{};
    for (int i = 0; i < 11; ++i) a.in[i] = (const float*)d_in[i];
    a.out = (float*)d_out; a.ws = (unsigned char*)d_ws;
    if (ONE_LAUNCH) { a.ph_lo = 0; a.ph_hi = NPH; a.li = 0; hipLaunchKernelGGL(mega_fwd, dim3(grid), dim3(NWAVES * 64), LDS_BYTES, stream, a); }
    else for (int p = 0; p < NPH; ++p) { a.ph_lo = p; a.ph_hi = p + 1; a.li = p; hipLaunchKernelGGL(mega_fwd, dim3(grid), dim3(NWAVES * 64), LDS_BYTES, stream, a); }
}
```
